# Optimizing an MI355X kernel written in HIP

```python
import jax, jax.numpy as jnp
from jax import lax
import numpy as np

D_MODEL = 1024
BATCH = 2
SEQ = 16384
DEPTH = 2

POOL_GROUPS = 4
POOL_GROUP_DIM = 64
POOL_WINDOWS = (2, 4, 8, 16)
POOL_DIM = POOL_GROUPS * POOL_GROUP_DIM
ATT_HEADS = 8
HEAD_DIM = 64
ATT_DIM = ATT_HEADS * HEAD_DIM
MOBA_BLOCK = 256
MOBA_TOPK = 3
MOBA_Q_CHUNK = 64
ROPE_THETA = 10000.0
SGU_GROUPS = 4
SGU_GROUP_DIM = 64
SGU_DIM = SGU_GROUPS * SGU_GROUP_DIM
SGU_CHUNK = 128
CONV_DIM = 256
CONV_WIDTH = 31
N_BRANCH = 4
FF_DIM = -(-8 * D_MODEL // (3 * 256)) * 256
IN_DIM = POOL_DIM + 3 * ATT_DIM + 2 * SGU_DIM + 2 * CONV_DIM
EPS = 1e-6
NEG = -1e30

kernel_name = 'hybrid_pool_moba_sgu_conv_gated_block'


def rms_norm(x, g):
    xf = x.astype(jnp.float32)
    y = xf * lax.rsqrt(jnp.mean(xf * xf, axis=-1, keepdims=True) + EPS)
    return (y * g.astype(jnp.float32)).astype(x.dtype)


def layer_norm(x, g, b):
    xf = x.astype(jnp.float32)
    mu = jnp.mean(xf, axis=-1, keepdims=True)
    var = jnp.mean(jnp.square(xf - mu), axis=-1, keepdims=True)
    y = (xf - mu) * lax.rsqrt(var + EPS)
    return (y * g.astype(jnp.float32) + b.astype(jnp.float32)).astype(x.dtype)


def rope(x, positions):
    half = HEAD_DIM // 2
    inv_freq = 1.0 / (ROPE_THETA ** (jnp.arange(half, dtype=jnp.float32) / half))
    ang = positions.astype(jnp.float32)[..., None] * inv_freq
    cos = jnp.cos(ang)[:, :, None, :]
    sin = jnp.sin(ang)[:, :, None, :]
    xf = x.astype(jnp.float32)
    x1, x2 = xf[..., :half], xf[..., half:]
    out = jnp.concatenate([x1 * cos - x2 * sin, x2 * cos + x1 * sin], axis=-1)
    return out.astype(x.dtype)


def pool_mixer(xa, pool_w, pool_scale):
    B, S, _ = xa.shape
    xf = xa.astype(jnp.float32).reshape(B, S, POOL_GROUPS, POOL_GROUP_DIM)
    cs = jnp.cumsum(xf, axis=1)
    t = jnp.arange(S)
    outs = []
    for g, w in enumerate(POOL_WINDOWS):
        c = cs[:, :, g]
        lagged = jnp.pad(c, ((0, 0), (w, 0), (0, 0)))[:, :S]
        cnt = jnp.minimum(t + 1, w).astype(jnp.float32)[None, :, None]
        outs.append((c - lagged) / cnt - xf[:, :, g])
    pooled = jnp.stack(outs, axis=2)
    mixed = jnp.einsum('bsgc,gcd->bsgd', pooled, pool_w.astype(jnp.float32))
    return (mixed.reshape(B, S, POOL_DIM) * pool_scale.astype(jnp.float32)).astype(xa.dtype)


def moba_attention(q, k, v):
    B, S, H, Dh = q.shape
    s_pad = -(-S // MOBA_BLOCK) * MOBA_BLOCK
    pad = ((0, 0), (0, s_pad - S), (0, 0), (0, 0))
    q, k, v = jnp.pad(q, pad), jnp.pad(k, pad), jnp.pad(v, pad)
    nb = s_pad // MOBA_BLOCK
    nq = s_pad // MOBA_Q_CHUNK
    top = min(MOBA_TOPK, nb)
    scale = HEAD_DIM ** -0.5
    kb = k.transpose(0, 2, 1, 3).reshape(B, H, nb, MOBA_BLOCK, Dh)
    vb = v.transpose(0, 2, 1, 3).reshape(B, H, nb, MOBA_BLOCK, Dh)
    kmean = jnp.mean(kb.astype(jnp.float32), axis=3)
    q_chunks = q.transpose(0, 2, 1, 3).reshape(B, H, nq, MOBA_Q_CHUNK, Dh).transpose(2, 0, 1, 3, 4)
    b_idx = jnp.arange(B)[:, None, None, None]
    h_idx = jnp.arange(H)[None, :, None, None]
    blk_ids = jnp.arange(nb)
    key_off = jnp.arange(MOBA_BLOCK)
    q_off = jnp.arange(MOBA_Q_CHUNK)

    def one_chunk(args):
        c, qc = args
        qf = qc.astype(jnp.float32)
        blk = (c * MOBA_Q_CHUNK) // MOBA_BLOCK
        gate = jnp.einsum('bhqd,bhnd->bhqn', qf, kmean)
        gate = jnp.where(blk_ids < blk, gate, NEG)
        _, sel = lax.top_k(gate, top)
        sel_valid = sel < blk
        ks = kb[b_idx, h_idx, sel].astype(jnp.float32)
        vs = vb[b_idx, h_idx, sel].astype(jnp.float32)
        s_sel = jnp.einsum('bhqd,bhqnkd->bhqnk', qf, ks) * scale
        s_sel = jnp.where(sel_valid[..., None], s_sel, NEG).reshape(B, H, MOBA_Q_CHUNK, top * MOBA_BLOCK)
        k_own = lax.dynamic_index_in_dim(kb, blk, axis=2, keepdims=False).astype(jnp.float32)
        v_own = lax.dynamic_index_in_dim(vb, blk, axis=2, keepdims=False).astype(jnp.float32)
        s_own = jnp.einsum('bhqd,bhkd->bhqk', qf, k_own) * scale
        q_pos = c * MOBA_Q_CHUNK + q_off
        k_pos = blk * MOBA_BLOCK + key_off
        s_own = jnp.where(k_pos[None, :] <= q_pos[:, None], s_own, NEG)
        p = jax.nn.softmax(jnp.concatenate([s_sel, s_own], axis=-1), axis=-1)
        p_sel = p[..., :top * MOBA_BLOCK].reshape(B, H, MOBA_Q_CHUNK, top, MOBA_BLOCK)
        p_own = p[..., top * MOBA_BLOCK:]
        o = jnp.einsum('bhqnk,bhqnkd->bhqd', p_sel, vs) + jnp.einsum('bhqk,bhkd->bhqd', p_own, v_own)
        return o.astype(qc.dtype)

    out = lax.map(one_chunk, (jnp.arange(nq), q_chunks))
    out = out.transpose(1, 0, 3, 2, 4).reshape(B, s_pad, H * Dh)
    return out[:, :S]


def spatial_gating(z, norm_g, norm_b, w_s, b_s):
    B, S, _ = z.shape
    u, v = z[..., :SGU_DIM], z[..., SGU_DIM:]
    v = layer_norm(v, norm_g, norm_b)
    nc = S // SGU_CHUNK
    vc = v.astype(jnp.float32).reshape(B, nc, SGU_CHUNK, SGU_GROUPS, SGU_GROUP_DIM)
    mask = jnp.tril(jnp.ones((SGU_CHUNK, SGU_CHUNK), dtype=bool))
    ws = jnp.where(mask[None], w_s.astype(jnp.float32), 0.0)
    f = jnp.einsum('gts,bnsgc->bntgc', ws, vc) + b_s.astype(jnp.float32).T[None, None, :, :, None]
    return (u.astype(jnp.float32) * f.reshape(B, S, SGU_DIM)).astype(z.dtype)


def conv_module(xd, conv_w, conv_b, norm_g, norm_b):
    a, g = xd[..., :CONV_DIM], xd[..., CONV_DIM:]
    h = a * jax.nn.sigmoid(g)
    h = lax.conv_general_dilated(
        h, conv_w[:, None, :], window_strides=(1,), padding=[(CONV_WIDTH - 1, 0)],
        dimension_numbers=('NWC', 'WIO', 'NWC'), feature_group_count=CONV_DIM) + conv_b
    return jax.nn.silu(layer_norm(h, norm_g, norm_b))


def setup_inputs(seed: int = 0) -> dict:
    key = jax.random.key(seed)
    ks = jax.random.split(key, 32)
    L, D = DEPTH, D_MODEL

    def nrm(k, shape, scale):
        return jax.random.normal(k, shape, jnp.float32) * scale

    x = nrm(ks[0], (BATCH, SEQ, D), 1.0)
    positions = (jax.random.randint(ks[1], (BATCH, 1), 0, 1024) + jnp.arange(SEQ)[None, :]).astype(jnp.int32)
    return {
        'x': x,
        'positions': positions,
        'norm_mix_g': 1.0 + nrm(ks[2], (L, D), 0.05),
        'w_in': nrm(ks[3], (L, D, IN_DIM), D ** -0.5),
        'w_gate': nrm(ks[4], (L, D, N_BRANCH * D), D ** -0.5),
        'b_gate': nrm(ks[5], (L, N_BRANCH * D), 0.1),
        'pool_w': nrm(ks[6], (L, POOL_GROUPS, POOL_GROUP_DIM, POOL_GROUP_DIM), POOL_GROUP_DIM ** -0.5),
        'pool_scale': 1.0 + nrm(ks[7], (L, POOL_DIM), 0.1),
        'sgu_norm_g': 1.0 + nrm(ks[8], (L, SGU_DIM), 0.05),
        'sgu_norm_b': nrm(ks[9], (L, SGU_DIM), 0.02),
        'sgu_w': nrm(ks[10], (L, SGU_GROUPS, SGU_CHUNK, SGU_CHUNK), SGU_CHUNK ** -0.5),
        'sgu_b': 1.0 + nrm(ks[11], (L, SGU_GROUPS, SGU_CHUNK), 0.1),
        'conv_w': nrm(ks[12], (L, CONV_WIDTH, CONV_DIM), CONV_WIDTH ** -0.5),
        'conv_b': nrm(ks[13], (L, CONV_DIM), 0.02),
        'conv_norm_g': 1.0 + nrm(ks[14], (L, CONV_DIM), 0.05),
        'conv_norm_b': nrm(ks[15], (L, CONV_DIM), 0.02),
        'w_proj_a': nrm(ks[16], (L, POOL_DIM, D), POOL_DIM ** -0.5),
        'w_proj_b': nrm(ks[17], (L, ATT_DIM, D), ATT_DIM ** -0.5),
        'w_proj_c': nrm(ks[18], (L, SGU_DIM, D), SGU_DIM ** -0.5),
        'w_proj_d': nrm(ks[19], (L, CONV_DIM, D), CONV_DIM ** -0.5),
        'w_o': nrm(ks[20], (L, D, D), D ** -0.5),
        'norm_ffn_g': 1.0 + nrm(ks[21], (L, D), 0.05),
        'w_ffn_in': nrm(ks[22], (L, D, 2 * FF_DIM), D ** -0.5),
        'w_ffn_out': nrm(ks[23], (L, FF_DIM, D), FF_DIM ** -0.5),
        'final_norm_g': 1.0 + nrm(ks[24], (D,), 0.05),
    }


def reference(x, positions, norm_mix_g, w_in, w_gate, b_gate, pool_w, pool_scale,
              sgu_norm_g, sgu_norm_b, sgu_w, sgu_b, conv_w, conv_b, conv_norm_g, conv_norm_b,
              w_proj_a, w_proj_b, w_proj_c, w_proj_d, w_o, norm_ffn_g, w_ffn_in, w_ffn_out,
              final_norm_g):
    B, S, D = x.shape
    splits = np.cumsum([POOL_DIM, ATT_DIM, ATT_DIM, ATT_DIM, 2 * SGU_DIM]).tolist()
    for l in range(DEPTH):
        xn = rms_norm(x, norm_mix_g[l])
        proj = xn @ w_in[l]
        xa, q, k, v, zc, xd = jnp.split(proj, splits, axis=-1)
        q = rope(q.reshape(B, S, ATT_HEADS, HEAD_DIM), positions)
        k = rope(k.reshape(B, S, ATT_HEADS, HEAD_DIM), positions)
        v = v.reshape(B, S, ATT_HEADS, HEAD_DIM)
        ya = pool_mixer(xa, pool_w[l], pool_scale[l])
        yb = moba_attention(q, k, v)
        yc = spatial_gating(jax.nn.gelu(zc), sgu_norm_g[l], sgu_norm_b[l], sgu_w[l], sgu_b[l])
        yd = conv_module(xd, conv_w[l], conv_b[l], conv_norm_g[l], conv_norm_b[l])
        gates = jax.nn.sigmoid((xn @ w_gate[l] + b_gate[l]).astype(jnp.float32)).reshape(B, S, N_BRANCH, D)
        merged = (gates[:, :, 0] * (ya @ w_proj_a[l]) + gates[:, :, 1] * (yb @ w_proj_b[l])
                  + gates[:, :, 2] * (yc @ w_proj_c[l]) + gates[:, :, 3] * (yd @ w_proj_d[l]))
        x = x + merged.astype(x.dtype) @ w_o[l]
        hn = rms_norm(x, norm_ffn_g[l])
        gu = hn @ w_ffn_in[l]
        x = x + (jax.nn.silu(gu[..., :FF_DIM]) * gu[..., FF_DIM:]) @ w_ffn_out[l]
    return rms_norm(x, final_norm_g)
```

```cpp
#include <hip/hip_runtime.h>
#include <hip/hip_cooperative_groups.h>
#include <cstdio>
namespace cg = cooperative_groups;
#define LAS __attribute__((address_space(3)))
#define DI __device__ __forceinline__
typedef unsigned short bf16_t;
typedef short bf16x8 __attribute__((ext_vector_type(8)));
typedef short s16x4 __attribute__((ext_vector_type(4)));
typedef float f32x4 __attribute__((ext_vector_type(4)));
typedef float f32x2 __attribute__((ext_vector_type(2)));
typedef unsigned u32x4 __attribute__((ext_vector_type(4)));
typedef unsigned u32x2 __attribute__((ext_vector_type(2)));

constexpr int SEQ = 16384, MTOK = 32768, DM = 1024, NIN = 2816, FF = 2816;
constexpr int LDS_BYTES = 131072;
constexpr size_t MiB = 1048576;
constexpr size_t WS_XB = 0, WS_WTS = 64 * MiB, WS_ROPE = 140 * MiB, WS_MISC = 148 * MiB, WS_Y = 150 * MiB, WS_R = 230 * MiB, WS_END = 494 * MiB;
constexpr size_t R_Q = 0, R_K = 32 * MiB, R_V = 64 * MiB, R_LISTS = 96 * MiB, R_ML = 128 * MiB, R_XA = 136 * MiB, R_ZC = 152 * MiB, R_H = 184 * MiB, R_PO = 136 * MiB;
constexpr size_t W_IN = 0, W_G = W_IN + (size_t)2816 * 1024, W_P = W_G + (size_t)4096 * 1024, W_O = W_P + (size_t)1024 * 1280, W_F1 = W_O + (size_t)1024 * 1024, W_F2 = W_F1 + (size_t)5632 * 1024, W_LAYER = W_F2 + (size_t)1024 * 2816;
constexpr size_t MISC_SS = 0, MISC_KM = 5 * (size_t)MTOK * 4, MISC_CNT = MISC_KM + 1024 * 64 * 4;

DI unsigned pk2(float lo, float hi) { unsigned r; asm volatile("v_cvt_pk_bf16_f32 %0, %1, %2" : "=v"(r) : "v"(lo), "v"(hi)); return r; }
DI float bflo(unsigned u) { return __uint_as_float(u << 16); }
DI float bfhi(unsigned u) { return __uint_as_float(u & 0xffff0000u); }
DI float bf1(bf16_t u) { return __uint_as_float(((unsigned)u) << 16); }
DI float sigm(float z) { return __builtin_amdgcn_rcpf(1.0f + __expf(-z)); }
DI float gelu_t(float x) { return x * sigm(1.5957691216057308f * (x + 0.044715f * x * x * x)); }
DI u32x2 pk4(f32x4 v) { u32x2 w; w.x = pk2(v[0], v[1]); w.y = pk2(v[2], v[3]); return w; }

DI int l_tid() { int t = threadIdx.x; asm volatile("" : "+v"(t)); return t; }
DI int l_bid() { int b = blockIdx.x; asm volatile("" : "+s"(b)); return b; }
DI int l_gdim() { int b = gridDim.x; asm volatile("" : "+s"(b)); return b; }
struct Params { const float* in[25]; float* out; unsigned char* ws; };

namespace pg8 {
constexpr int BM = 256, BK = 64, HALF = 128, HTB = HALF * BK * 2, STAGE_BYTES = 8 * HTB, NXCD = 8, WGM = 8;
DI int lds_byte(int r, int c) { const int st = (r >> 4) * 2 + (c >> 5), rr = r & 15, cc = c & 31, ob = rr * 64 + cc * 2; return st * 1024 + (ob ^ (((ob >> 9) & 1) << 5)); }
DI void stage_rc(int b, int& R, int& C) { const int st = b / 1024, sb = b % 1024, swz = sb ^ (((sb >> 9) & 1) << 5); R = (st >> 1) * 16 + swz / 64; C = (st & 1) * 32 + (swz % 64) / 2; }
DI int perm32(int rho) { const int n = rho >> 4, i = rho & 15; return 8 * (i >> 2) + 4 * n + (i & 3); }
struct Unit { int pm, pn, nt, aux; size_t aoff, boff; };
template <int MODE, int NN, int LDA, int LDB, int NT0>
struct Sched {
    static constexpr int nM = MTOK / BM, nN = NN, nwg = nM * nN, lda = LDA, ldb = LDB;
    int G, c;
    DI bool next(int i, Unit& u) const {
        const int L = i * G + c; if (L >= nwg) return false;
        int wgid = L; { constexpr int q = nwg / NXCD; const int xcd = wgid % NXCD, off = wgid / NXCD; wgid = xcd * q + off; }
        constexpr int nig = WGM * nN; const int gid = wgid / nig, fm = gid * WGM;
        const int pm = fm + ((wgid % nig) % WGM), pn = (wgid % nig) / WGM;
        u.pm = pm;
        if (MODE == 0) { u.pn = pn; u.aux = 0; u.nt = NT0; u.aoff = (size_t)pm * BM * lda * 2; u.boff = (size_t)pn * BM * ldb * 2; }
        else { const int br = pn >> 2, pi = pn & 3; const int koff = br == 0 ? 0 : (br == 1 ? 256 : (br == 2 ? 768 : 1024));
               u.pn = pi; u.aux = br; u.nt = br == 1 ? 8 : 4; u.aoff = ((size_t)pm * BM * lda + koff) * 2; u.boff = ((size_t)pi * BM * ldb + koff) * 2; }
        return true;
    }
};

template <class Epi, class SchedT>
DI void gemm_phase(LAS unsigned char* lds, const bf16_t* A, const bf16_t* Bt, const SchedT& S, const Epi& E) {
    const int tid = l_tid(), wid = __builtin_amdgcn_readfirstlane(tid >> 6), lane = tid & 63, wr = wid >> 2, wc = wid & 3, fr = lane & 15, fq = lane >> 4;
    constexpr int lda = SchedT::lda, ldb = SchedT::ldb;
    unsigned voffA[2], voffB[2];
#pragma unroll
    for (int i = 0; i < 2; ++i) { int R, C; stage_rc(tid * 16 + i * 8192, R, C); const int Rb = Epi::PERM ? ((R & ~31) + perm32(R & 31)) : R;
        voffA[i] = (unsigned)(R * lda + C) * 2u; voffB[i] = (unsigned)(Rb * ldb + C) * 2u; }
    const size_t kstep = (size_t)(BK * 2);
    const size_t hstepA = (size_t)HALF * lda * 2, hstepB = (size_t)HALF * ldb * 2;
    const unsigned ldsw = (unsigned)wid * 1024u;
    const int aoff = lds_byte(wr * 64 + fr, fq * 8), boff = lds_byte(wc * 32 + fr, fq * 8);
#define PG8_SA(b, h) (((b) * 2 + (h)) * HTB)
#define PG8_SB(b, h) ((4 + (b) * 2 + (h)) * HTB)
#define PG8_STAGE(bufoff, gbase, voff) do { _Pragma("unroll") for (int _i = 0; _i < 2; ++_i) \
        __builtin_amdgcn_global_load_lds((const unsigned*)((const char*)(gbase) + (voff)[_i]), (LAS unsigned*)(lds + (bufoff) + ldsw + _i * 8192), 16, 0, 0); } while (0)
#define PG8_LDA(dst, b, h) do { _Pragma("unroll") for (int m = 0; m < 4; ++m) _Pragma("unroll") for (int k = 0; k < 2; ++k) dst[m][k] = *(const LAS bf16x8*)(lds + PG8_SA(b, h) + aoff + m * 2048 + k * 1024); } while (0)
#define PG8_LDB(dst, b, h) do { _Pragma("unroll") for (int n = 0; n < 2; ++n) _Pragma("unroll") for (int k = 0; k < 2; ++k) dst[n][k] = *(const LAS bf16x8*)(lds + PG8_SB(b, h) + boff + n * 2048 + k * 1024); } while (0)
#define PG8_MMA(ai, bj, At, Bt_) do { __builtin_amdgcn_s_setprio(1); _Pragma("unroll") for (int m = 0; m < 4; ++m) _Pragma("unroll") for (int n = 0; n < 2; ++n) _Pragma("unroll") for (int k = 0; k < 2; ++k) \
        acc[ai][bj][m][n] = __builtin_amdgcn_mfma_f32_16x16x32_bf16(Bt_[n][k], At[m][k], acc[ai][bj][m][n], 0, 0, 0); __builtin_amdgcn_s_setprio(0); } while (0)
#define PG8_WAIT_V(n) asm volatile("s_waitcnt vmcnt(" #n ")" ::: "memory")
#define PG8_WAIT_L(n) asm volatile("s_waitcnt lgkmcnt(" #n ")" ::: "memory")
#define PG8_BAR __builtin_amdgcn_s_barrier()
#define PG8_SCHED __builtin_amdgcn_sched_barrier(0)
    Unit cur, nxt; int ui = 0;
    if (!S.next(0, cur)) return;
    f32x4 acc[2][2][4][2];
#pragma unroll
    for (int a = 0; a < 2; ++a)
#pragma unroll
        for (int b = 0; b < 2; ++b)
#pragma unroll
            for (int m = 0; m < 4; ++m)
#pragma unroll
                for (int n = 0; n < 2; ++n) acc[a][b][m][n] = (f32x4){0.f, 0.f, 0.f, 0.f};
    bf16x8 At[4][2], B0[2][2], B1[2][2];
    const char* cA = (const char*)A + cur.aoff; const char* cB = (const char*)Bt + cur.boff;
    PG8_STAGE(PG8_SB(0, 0), cB, voffB); PG8_STAGE(PG8_SA(0, 0), cA, voffA); PG8_STAGE(PG8_SB(0, 1), cB + hstepB, voffB); PG8_STAGE(PG8_SA(0, 1), cA + hstepA, voffA);
    if (wr == 1) PG8_BAR;
    PG8_WAIT_V(4); PG8_BAR;
    PG8_STAGE(PG8_SB(1, 0), cB + kstep, voffB); PG8_STAGE(PG8_SA(1, 0), cA + kstep, voffA); PG8_STAGE(PG8_SB(1, 1), cB + hstepB + kstep, voffB);
    PG8_WAIT_V(6); PG8_BAR;
    for (;;) {
        const bool has_next = S.next(ui + 1, nxt);
        const char* nA = has_next ? (const char*)A + nxt.aoff : cA; const char* nB = has_next ? (const char*)Bt + nxt.boff : cB;
        const int nt = cur.nt;
        for (int t = 0; t < nt; t += 2) {
            const bool last = (t == nt - 2);
            const char* a1 = cA + (size_t)(t + 1) * kstep;
            const char* a2 = last ? nA : cA + (size_t)(t + 2) * kstep; const char* b2 = last ? nB : cB + (size_t)(t + 2) * kstep;
            const char* a3 = a2 + kstep; const char* b3 = b2 + kstep;
            PG8_LDB(B0, 0, 0); PG8_SCHED; PG8_LDA(At, 0, 0); PG8_STAGE(PG8_SA(1, 1), a1 + hstepA, voffA);
            PG8_WAIT_L(8); PG8_BAR; PG8_WAIT_L(0); PG8_MMA(0, 0, At, B0); PG8_BAR; PG8_SCHED;
            PG8_LDB(B1, 0, 1); PG8_STAGE(PG8_SB(0, 0), b2, voffB);
            PG8_BAR; PG8_WAIT_L(0); PG8_MMA(0, 1, At, B1); PG8_BAR;
            PG8_LDA(At, 0, 1); PG8_STAGE(PG8_SA(0, 0), a2, voffA);
            PG8_BAR; PG8_WAIT_L(0); PG8_MMA(1, 0, At, B0); PG8_BAR; PG8_SCHED;
            PG8_STAGE(PG8_SB(0, 1), b2 + hstepB, voffB);
            PG8_WAIT_V(6); PG8_BAR; PG8_MMA(1, 1, At, B1); PG8_BAR;
            PG8_LDB(B0, 1, 0); PG8_SCHED; PG8_LDA(At, 1, 0); PG8_STAGE(PG8_SA(0, 1), a2 + hstepA, voffA);
            PG8_WAIT_L(8); PG8_BAR; PG8_WAIT_L(0); PG8_MMA(0, 0, At, B0); PG8_BAR; PG8_SCHED;
            PG8_LDB(B1, 1, 1); PG8_STAGE(PG8_SB(1, 0), b3, voffB);
            PG8_BAR; PG8_WAIT_L(0); PG8_MMA(0, 1, At, B1); PG8_BAR;
            PG8_LDA(At, 1, 1); PG8_STAGE(PG8_SA(1, 0), a3, voffA);
            PG8_BAR; PG8_WAIT_L(0); PG8_MMA(1, 0, At, B0); PG8_BAR; PG8_SCHED;
            PG8_STAGE(PG8_SB(1, 1), b3 + hstepB, voffB);
            PG8_WAIT_V(6); PG8_BAR; PG8_MMA(1, 1, At, B1); PG8_BAR;
        }
        E(acc, cur, wr, wc, fr, fq);
        if (!has_next) break;
#pragma unroll
        for (int a = 0; a < 2; ++a)
#pragma unroll
            for (int b = 0; b < 2; ++b)
#pragma unroll
                for (int m = 0; m < 4; ++m)
#pragma unroll
                    for (int n = 0; n < 2; ++n) acc[a][b][m][n] = (f32x4){0.f, 0.f, 0.f, 0.f};
        cur = nxt; cA = nA; cB = nB; ++ui;
    }
    PG8_WAIT_V(0);
    if (wr == 0) PG8_BAR;
    PG8_BAR;
#undef PG8_SA
#undef PG8_SB
#undef PG8_STAGE
#undef PG8_LDA
#undef PG8_LDB
#undef PG8_MMA
#undef PG8_WAIT_V
#undef PG8_WAIT_L
#undef PG8_BAR
#undef PG8_SCHED
}
}
using pg8::Unit;
typedef const f32x4 (&AccRef)[2][2][4][2];
struct EpiIn {
    static constexpr bool PERM = true;
    unsigned char* ws; int ssi;
    template <int TY> DI void run(AccRef acc, const Unit& u, int wr, int wc, int fr, int fq) const {
        const int pn = u.pn;
        const float* ss = (const float*)(ws + WS_MISC + MISC_SS) + (size_t)ssi * MTOK; const float* rope = (const float*)(ws + WS_ROPE);
        bf16_t* XA = (bf16_t*)(ws + WS_R + R_XA); bf16_t* Q = (bf16_t*)(ws + WS_R + R_Q); bf16_t* K = (bf16_t*)(ws + WS_R + R_K); bf16_t* V = (bf16_t*)(ws + WS_R + R_V);
        bf16_t* ZC = (bf16_t*)(ws + WS_R + R_ZC); bf16_t* H = (bf16_t*)(ws + WS_R + R_H);
#pragma unroll
        for (int ai = 0; ai < 2; ++ai)
#pragma unroll
            for (int m = 0; m < 4; ++m) {
                const int row = u.pm * 256 + ai * 128 + wr * 64 + m * 16 + fr;
                const float rs = rsqrtf(ss[row] * (1.0f / 1024.0f) + 1e-6f);
#pragma unroll
                for (int bj = 0; bj < 2; ++bj) {
                    const f32x4 v0 = acc[ai][bj][m][0] * rs, v1 = acc[ai][bj][m][1] * rs;
                    if (TY == 0) {
                        bf16_t* dst; int ld, cb;
                        if (pn == 0) { dst = XA; ld = 256; cb = 0; } else { dst = V; ld = 512; cb = (pn - 5) * 256; }
                        u32x4 w; w.x = pk2(v0[0], v0[1]); w.y = pk2(v0[2], v0[3]); w.z = pk2(v1[0], v1[1]); w.w = pk2(v1[2], v1[3]);
                        *(u32x4*)(dst + (size_t)row * ld + cb + bj * 128 + wc * 32 + 8 * fq) = w;
                    } else if (TY == 1) {
                        u32x4 w; w.x = pk2(gelu_t(v0[0]), gelu_t(v0[1])); w.y = pk2(gelu_t(v0[2]), gelu_t(v0[3])); w.z = pk2(gelu_t(v1[0]), gelu_t(v1[1])); w.w = pk2(gelu_t(v1[2]), gelu_t(v1[3]));
                        *(u32x4*)(ZC + (size_t)row * 512 + (pn - 7) * 256 + bj * 128 + wc * 32 + 8 * fq) = w;
                    } else if (TY == 2) {
                        bf16_t* dst = pn >= 3 ? K : Q; const int hb = ((pn - 1) & 1) * 4 + bj * 2 + (wc >> 1); const int idx = 16 * (wc & 1) + 4 * fq;
                        const f32x4 r0 = *(const f32x4*)(rope + ((size_t)row * 32 + idx) * 2), r1 = *(const f32x4*)(rope + ((size_t)row * 32 + idx) * 2 + 4);
                        f32x4 o1, o2;
                        o1[0] = v0[0] * r0[0] - v1[0] * r0[1]; o2[0] = v1[0] * r0[0] + v0[0] * r0[1];
                        o1[1] = v0[1] * r0[2] - v1[1] * r0[3]; o2[1] = v1[1] * r0[2] + v0[1] * r0[3];
                        o1[2] = v0[2] * r1[0] - v1[2] * r1[1]; o2[2] = v1[2] * r1[0] + v0[2] * r1[1];
                        o1[3] = v0[3] * r1[2] - v1[3] * r1[3]; o2[3] = v1[3] * r1[2] + v0[3] * r1[3];
                        bf16_t* p = dst + (size_t)row * 512 + hb * 64 + idx;
                        *(u32x2*)p = pk4(o1); *(u32x2*)(p + 32) = pk4(o2);
                    } else {
                        const int blk = (pn - 9) * 4 + bj * 2 + (wc >> 1); const int idx = 32 * blk + 16 * (wc & 1) + 4 * fq;
                        f32x4 o; o[0] = v0[0] * sigm(v1[0]); o[1] = v0[1] * sigm(v1[1]); o[2] = v0[2] * sigm(v1[2]); o[3] = v0[3] * sigm(v1[3]);
                        *(u32x2*)(H + (size_t)row * 256 + idx) = pk4(o);
                    }
                }
            }
    }
    DI void operator()(AccRef acc, const Unit& u, int wr, int wc, int fr, int fq) const {
        const int pn = u.pn;
        if (pn == 0 || pn == 5 || pn == 6) run<0>(acc, u, wr, wc, fr, fq);
        else if (pn == 7 || pn == 8) run<1>(acc, u, wr, wc, fr, fq);
        else if (pn <= 4) run<2>(acc, u, wr, wc, fr, fq);
        else run<3>(acc, u, wr, wc, fr, fq);
    }
};
struct EpiProj {
    static constexpr bool PERM = true;
    bf16_t* P;
    DI void operator()(AccRef acc, const Unit& u, int wr, int wc, int fr, int fq) const {
        const int br = u.aux;
#pragma unroll
        for (int ai = 0; ai < 2; ++ai)
#pragma unroll
            for (int m = 0; m < 4; ++m) {
                const int row = u.pm * 256 + ai * 128 + wr * 64 + m * 16 + fr;
#pragma unroll
                for (int bj = 0; bj < 2; ++bj)
#pragma unroll
                    for (int n = 0; n < 2; ++n) {
                        const int j = u.pn * 256 + bj * 128 + wc * 32 + 8 * fq + 4 * n, jj = j & 63;
                        const int pos = 256 * (j >> 6) + 128 * (br >> 1) + 32 * (jj >> 4) + 8 * ((jj >> 2) & 3) + 4 * (br & 1);
                        *(u32x2*)(P + (size_t)row * 4096 + pos) = pk4(acc[ai][bj][m][n]);
                    }
            }
    }
};
struct EpiGate {
    static constexpr bool PERM = true;
    const float* ss; const float* bg; const bf16_t* P; bf16_t* MG;
    DI void operator()(AccRef acc, const Unit& u, int wr, int wc, int fr, int fq) const {
        const int oc = u.pn * 64 + 16 * wc + 4 * fq;
        f32x4 bv[2][2];
#pragma unroll
        for (int bj = 0; bj < 2; ++bj)
#pragma unroll
            for (int n = 0; n < 2; ++n) bv[bj][n] = *(const f32x4*)(bg + (2 * bj + n) * 1024 + oc);
#pragma unroll
        for (int ai = 0; ai < 2; ++ai)
#pragma unroll
            for (int m = 0; m < 4; ++m) {
                const int row = u.pm * 256 + ai * 128 + wr * 64 + m * 16 + fr;
                const float rs = rsqrtf(ss[row] * (1.0f / 1024.0f) + 1e-6f);
                f32x4 o = (f32x4){0.f, 0.f, 0.f, 0.f};
#pragma unroll
                for (int bj = 0; bj < 2; ++bj) {
                    const u32x4 pv = *(const u32x4*)(P + (size_t)row * 4096 + u.pn * 256 + bj * 128 + wc * 32 + 8 * fq);
                    const f32x4 g0 = acc[ai][bj][m][0] * rs + bv[bj][0], g1 = acc[ai][bj][m][1] * rs + bv[bj][1];
                    o[0] += sigm(g0[0]) * bflo(pv.x) + sigm(g1[0]) * bflo(pv.z);
                    o[1] += sigm(g0[1]) * bfhi(pv.x) + sigm(g1[1]) * bfhi(pv.z);
                    o[2] += sigm(g0[2]) * bflo(pv.y) + sigm(g1[2]) * bflo(pv.w);
                    o[3] += sigm(g0[3]) * bfhi(pv.y) + sigm(g1[3]) * bfhi(pv.w);
                }
                *(u32x2*)(MG + (size_t)row * 1024 + oc) = pk4(o);
            }
    }
};
struct EpiRes {
    static constexpr bool PERM = false;
    const float* base; float* X; bf16_t* XB; float* ss;
    DI void operator()(AccRef acc, const Unit& u, int wr, int wc, int fr, int fq) const {
#pragma unroll
        for (int ai = 0; ai < 2; ++ai)
#pragma unroll
            for (int m = 0; m < 4; ++m) {
                const int row = u.pm * 256 + ai * 128 + wr * 64 + m * 16 + fr; float sq = 0.f;
#pragma unroll
                for (int bj = 0; bj < 2; ++bj)
#pragma unroll
                    for (int n = 0; n < 2; ++n) {
                        const size_t off = (size_t)row * 1024 + u.pn * 256 + bj * 128 + wc * 32 + n * 16 + 4 * fq;
                        const f32x4 v = *(const f32x4*)(base + off) + acc[ai][bj][m][n];
                        *(f32x4*)(X + off) = v; *(u32x2*)(XB + off) = pk4(v);
                        sq += (v[0] * v[0] + v[1] * v[1]) + (v[2] * v[2] + v[3] * v[3]);
                    }
                sq += __shfl_xor(sq, 16); sq += __shfl_xor(sq, 32);
                if (fq == 0) atomicAdd(ss + row, sq);
            }
    }
};
struct EpiSwi {
    static constexpr bool PERM = true;
    const float* ss; bf16_t* ACT;
    DI void operator()(AccRef acc, const Unit& u, int wr, int wc, int fr, int fq) const {
#pragma unroll
        for (int ai = 0; ai < 2; ++ai)
#pragma unroll
            for (int m = 0; m < 4; ++m) {
                const int row = u.pm * 256 + ai * 128 + wr * 64 + m * 16 + fr;
                const float rs = rsqrtf(ss[row] * (1.0f / 1024.0f) + 1e-6f);
#pragma unroll
                for (int bj = 0; bj < 2; ++bj) {
                    const f32x4 g = acc[ai][bj][m][0] * rs, uu = acc[ai][bj][m][1] * rs;
                    const int blk = u.pn * 4 + bj * 2 + (wc >> 1), idx = 32 * blk + 16 * (wc & 1) + 4 * fq;
                    f32x4 o; o[0] = g[0] * sigm(g[0]) * uu[0]; o[1] = g[1] * sigm(g[1]) * uu[1]; o[2] = g[2] * sigm(g[2]) * uu[2]; o[3] = g[3] * sigm(g[3]) * uu[3];
                    *(u32x2*)(ACT + (size_t)row * FF + idx) = pk4(o);
                }
            }
    }
};
struct LayerW { const float *g_mix, *w_in, *w_gate, *b_gate, *pool_w, *pool_scale, *sgu_g, *sgu_b, *sgu_w, *sgu_bs, *conv_w, *conv_b, *conv_g, *conv_nb, *wpa, *wpb, *wpc, *wpd, *wo, *g_ffn, *wf1, *wf2; };
DI LayerW layer_w(const Params& p, int l) {
    LayerW w;
    w.g_mix = p.in[2] + (size_t)l * 1024; w.w_in = p.in[3] + (size_t)l * 1024 * 2816; w.w_gate = p.in[4] + (size_t)l * 1024 * 4096; w.b_gate = p.in[5] + (size_t)l * 4096;
    w.pool_w = p.in[6] + (size_t)l * 4 * 64 * 64; w.pool_scale = p.in[7] + (size_t)l * 256; w.sgu_g = p.in[8] + (size_t)l * 256; w.sgu_b = p.in[9] + (size_t)l * 256;
    w.sgu_w = p.in[10] + (size_t)l * 4 * 128 * 128; w.sgu_bs = p.in[11] + (size_t)l * 4 * 128; w.conv_w = p.in[12] + (size_t)l * 31 * 256; w.conv_b = p.in[13] + (size_t)l * 256;
    w.conv_g = p.in[14] + (size_t)l * 256; w.conv_nb = p.in[15] + (size_t)l * 256; w.wpa = p.in[16] + (size_t)l * 256 * 1024; w.wpb = p.in[17] + (size_t)l * 512 * 1024;
    w.wpc = p.in[18] + (size_t)l * 256 * 1024; w.wpd = p.in[19] + (size_t)l * 256 * 1024; w.wo = p.in[20] + (size_t)l * 1024 * 1024; w.g_ffn = p.in[21] + (size_t)l * 1024;
    w.wf1 = p.in[22] + (size_t)l * 1024 * 5632; w.wf2 = p.in[23] + (size_t)l * 2816 * 1024;
    return w;
}
DI int orig_in(int nl) {
    const int tile = nl >> 8;
    if (tile == 0 || (tile >= 5 && tile <= 8)) return nl;
    const int l = nl & 63, w = l >> 5, fq = (l >> 3) & 3, n = (l >> 2) & 1, e = l & 3, idx = 16 * w + 4 * fq + e;
    if (tile <= 4) return (nl & ~63) + 32 * n + idx;
    const int blk = (nl - 2304) >> 6; return 2304 + (n ? 256 : 0) + 32 * blk + idx;
}
DI int orig_gate(int nl) { const int pn = nl >> 8, l = nl & 255, bj = l >> 7, wc = (l >> 5) & 3, fq = (l >> 3) & 3, n = (l >> 2) & 1, e = l & 3; return (2 * bj + n) * 1024 + 64 * pn + 16 * wc + 4 * fq + e; }
DI int orig_ffn(int nl) { const int blk = nl >> 6, l = nl & 63, w = l >> 5, fq = (l >> 3) & 3, n = (l >> 2) & 1, e = l & 3; const int idx = 32 * blk + 16 * w + 4 * fq + e; return n ? 2816 + idx : idx; }

DI void prep_weights(const Params& p, LAS float* tile, bf16_t* wts) {
    const int TIDX = l_tid(), BIDX = l_bid(), GDIM = l_gdim(); (void)TIDX; (void)BIDX; (void)GDIM;
    const int tid = TIDX;
    for (int job = BIDX; job < 2 * 4416; job += GDIM) {
        const int l = job / 4416; int j = job % 4416; int type, tn, tk;
        if (j < 704) { type = 0; tn = j / 16; tk = j % 16; }
        else if (j < 1728) { j -= 704; type = 1; tn = j / 16; tk = j % 16; }
        else if (j < 2048) { j -= 1728; type = 2; tn = j / 20; tk = j % 20; }
        else if (j < 2304) { j -= 2048; type = 3; tn = j / 16; tk = j % 16; }
        else if (j < 3712) { j -= 2304; type = 4; tn = j / 16; tk = j % 16; }
        else { j -= 3712; type = 5; tn = j / 44; tk = j % 44; }
        const LayerW w = layer_w(p, l);
        const int n0 = tn * 64, k0 = tk * 64;
        __syncthreads();
        {
            const int n = tid & 63, kb = tid >> 6, nl = n0 + n;
            const int oc = type == 0 ? orig_in(nl) : (type == 1 ? orig_gate(nl) : (type == 4 ? orig_ffn(nl) : nl));
#pragma unroll
            for (int i = 0; i < 8; ++i) {
                const int k = k0 + kb + 8 * i; float v;
                if (type == 0) v = w.g_mix[k] * w.w_in[(size_t)k * 2816 + oc];
                else if (type == 1) v = w.g_mix[k] * w.w_gate[(size_t)k * 4096 + oc];
                else if (type == 2) {
                    if (k < 256) { const int g = k >> 6; float s = 0.f;
                        for (int d = 0; d < 64; ++d) s += w.pool_w[(size_t)k * 64 + d] * w.pool_scale[g * 64 + d] * w.wpa[(size_t)(g * 64 + d) * 1024 + oc];
                        v = s; }
                    else if (k < 768) v = w.wpb[(size_t)(k - 256) * 1024 + oc];
                    else if (k < 1024) v = w.wpc[(size_t)(k - 768) * 1024 + oc];
                    else v = w.wpd[(size_t)(k - 1024) * 1024 + oc];
                }
                else if (type == 3) v = w.wo[(size_t)k * 1024 + oc];
                else if (type == 4) v = w.g_ffn[k] * w.wf1[(size_t)k * 5632 + oc];
                else v = w.wf2[(size_t)k * 1024 + oc];
                tile[(kb + 8 * i) * 65 + n] = v;
            }
        }
        __syncthreads();
        {
            const int nn = tid >> 3, kc = (tid & 7) * 8;
            u32x4 o;
            o.x = pk2(tile[(kc + 0) * 65 + nn], tile[(kc + 1) * 65 + nn]); o.y = pk2(tile[(kc + 2) * 65 + nn], tile[(kc + 3) * 65 + nn]);
            o.z = pk2(tile[(kc + 4) * 65 + nn], tile[(kc + 5) * 65 + nn]); o.w = pk2(tile[(kc + 6) * 65 + nn], tile[(kc + 7) * 65 + nn]);
            const size_t woff = type == 0 ? W_IN : (type == 1 ? W_G : (type == 2 ? W_P : (type == 3 ? W_O : (type == 4 ? W_F1 : W_F2))));
            const int ldd = type == 2 ? 1280 : (type == 5 ? 2816 : 1024);
            *(u32x4*)(wts + (size_t)l * W_LAYER + woff + (size_t)(n0 + nn) * ldd + k0 + kc) = o;
        }
    }
}
DI void phase0_misc(const Params& p, bf16_t* XB, float* ss, float* rope, int* cnt) {
    const int TIDX = l_tid(), BIDX = l_bid(), GDIM = l_gdim(); (void)TIDX; (void)BIDX; (void)GDIM;
    const int tid = TIDX, lane = tid & 63, wid = tid >> 6;
    const size_t gsz = (size_t)GDIM * 512, gid = (size_t)BIDX * 512 + tid;
    const float* x = p.in[0];
    for (int row = BIDX * 8 + wid; row < MTOK; row += GDIM * 8) {
        float sq = 0.f;
#pragma unroll
        for (int i = 0; i < 4; ++i) { const size_t off = (size_t)row * 1024 + i * 256 + lane * 4; const f32x4 v = *(const f32x4*)(x + off); sq += (v[0] * v[0] + v[1] * v[1]) + (v[2] * v[2] + v[3] * v[3]); *(u32x2*)(XB + off) = pk4(v); }
#pragma unroll
        for (int o = 32; o >= 1; o >>= 1) sq += __shfl_xor(sq, o);
        if (lane == 0) ss[row] = sq;
    }
    const int* pos = (const int*)p.in[1];
    for (size_t i = gid; i < (size_t)MTOK * 32; i += gsz) {
        const int row = (int)(i >> 5), fi = (int)(i & 31);
        const float inv = 1.0f / powf(10000.0f, (float)fi * (1.0f / 32.0f));
        const float ang = (float)pos[row] * inv;
        const double r = (double)ang * 0.15915494309189535; const float fr = (float)(r - rint(r));
        rope[i * 2] = __builtin_amdgcn_cosf(fr); rope[i * 2 + 1] = __builtin_amdgcn_sinf(fr);
    }
    for (size_t i = gid; i < (size_t)4 * MTOK; i += gsz) ss[MTOK + i] = 0.f;
    for (size_t i = gid; i < 2048; i += gsz) cnt[i] = 0;
}

DI void kmean_phase(const bf16_t* K, float* km) {
    const int TIDX = l_tid(), BIDX = l_bid(), GDIM = l_gdim(); (void)TIDX; (void)BIDX; (void)GDIM;
    const int lane = TIDX & 63, wid = TIDX >> 6, dp = lane & 31, par = lane >> 5;
    for (int it = BIDX * 8 + wid; it < 1024; it += GDIM * 8) {
        const int b = it >> 9, h = (it >> 6) & 7, n = it & 63;
        const bf16_t* base = K + ((size_t)(b * SEQ + n * 256)) * 512 + h * 64 + 2 * dp;
        float s0 = 0.f, s1 = 0.f;
#pragma unroll 16
        for (int i = 0; i < 128; ++i) { const unsigned u = *(const unsigned*)(base + (size_t)(2 * i + par) * 512); s0 += bflo(u); s1 += bfhi(u); }
        s0 += __shfl_xor(s0, 32); s1 += __shfl_xor(s1, 32);
        if (par == 0) { f32x2 o; o.x = s0 * (1.0f / 256.0f); o.y = s1 * (1.0f / 256.0f); *(f32x2*)(km + (size_t)it * 64 + 2 * dp) = o; }
    }
}
DI void pool_phase(const bf16_t* XA, bf16_t* Y) {
    const int TIDX = l_tid(), BIDX = l_bid(), GDIM = l_gdim(); (void)TIDX; (void)BIDX; (void)GDIM;
    const size_t gsz = (size_t)GDIM * 512, gid = (size_t)BIDX * 512 + TIDX;
    for (size_t idx = gid; idx < (size_t)MTOK * 32; idx += gsz) {
        const int tok = (int)(idx >> 5), ch = (int)(idx & 31) * 8, g = ch >> 6, w = 2 << g, tl = tok & (SEQ - 1);
        float a[8], c0[8];
#pragma unroll
        for (int i = 0; i < 8; ++i) a[i] = 0.f;
        const int cntw = tl + 1 < w ? tl + 1 : w;
        for (int j = 0; j < cntw; ++j) {
            const u32x4 v = *(const u32x4*)(XA + (size_t)(tok - j) * 256 + ch);
            const float f[8] = {bflo(v.x), bfhi(v.x), bflo(v.y), bfhi(v.y), bflo(v.z), bfhi(v.z), bflo(v.w), bfhi(v.w)};
#pragma unroll
            for (int i = 0; i < 8; ++i) { a[i] += f[i]; if (j == 0) c0[i] = f[i]; }
        }
        const float inv = 1.0f / (float)cntw;
        u32x4 o; o.x = pk2(a[0] * inv - c0[0], a[1] * inv - c0[1]); o.y = pk2(a[2] * inv - c0[2], a[3] * inv - c0[3]); o.z = pk2(a[4] * inv - c0[4], a[5] * inv - c0[5]); o.w = pk2(a[6] * inv - c0[6], a[7] * inv - c0[7]);
        *(u32x4*)(Y + (size_t)tok * 1280 + ch) = o;
    }
}
DI void conv_phase(LAS unsigned char* lds, const bf16_t* H, const LayerW& w, bf16_t* Y) {
    const int TIDX = l_tid(), BIDX = l_bid(), GDIM = l_gdim(); (void)TIDX; (void)BIDX; (void)GDIM;
    LAS bf16_t* HS = (LAS bf16_t*)lds;
    LAS float* CS = (LAS float*)(lds + 48128);
    const int tid = TIDX, lane = tid & 63, wid = tid >> 6;
    for (int tile = BIDX; tile < MTOK / 64; tile += GDIM) {
        const int t0 = tile * 64, tl0 = t0 & (SEQ - 1);
        __syncthreads();
        for (int q = tid; q < 94 * 32; q += 512) { const int r = q >> 5, cc = (q & 31) * 8; u32x4 v = (u32x4){0u, 0u, 0u, 0u};
            if (tl0 - 30 + r >= 0) v = *(const u32x4*)(H + (size_t)(t0 - 30 + r) * 256 + cc);
            *(LAS u32x4*)(HS + r * 256 + cc) = v; }
        __syncthreads();
        {
            const int c = tid & 255, hf = tid >> 8; float wj[31];
#pragma unroll
            for (int j = 0; j < 31; ++j) wj[j] = w.conv_w[j * 256 + c];
            const float cb = w.conv_b[c];
            for (int chunk = 0; chunk < 4; ++chunk) {
                const int base = 32 * hf + 8 * chunk; float o[8];
#pragma unroll
                for (int i = 0; i < 8; ++i) o[i] = cb;
#pragma unroll
                for (int i = 0; i < 38; ++i) { const float hv = bf1(HS[(base + i) * 256 + c]);
#pragma unroll
                    for (int oo = 0; oo < 8; ++oo) { const int j = i - oo; if (j >= 0 && j < 31) o[oo] += wj[j] * hv; } }
#pragma unroll
                for (int oo = 0; oo < 8; ++oo) CS[(base + oo) * 260 + c] = o[oo];
            }
        }
        __syncthreads();
        {
            const f32x4 gg = *(const f32x4*)(w.conv_g + 4 * lane), bb = *(const f32x4*)(w.conv_nb + 4 * lane);
            for (int i = 0; i < 8; ++i) { const int tk = wid * 8 + i;
                const f32x4 v = *(const LAS f32x4*)(CS + tk * 260 + 4 * lane);
                float s = (v[0] + v[1]) + (v[2] + v[3]);
#pragma unroll
                for (int o = 32; o >= 1; o >>= 1) s += __shfl_xor(s, o);
                const float mu = s * (1.0f / 256.0f); const f32x4 d = v - mu;
                float q = (d[0] * d[0] + d[1] * d[1]) + (d[2] * d[2] + d[3] * d[3]);
#pragma unroll
                for (int o = 32; o >= 1; o >>= 1) q += __shfl_xor(q, o);
                const float rstd = rsqrtf(q * (1.0f / 256.0f) + 1e-6f);
                f32x4 y = d * rstd * gg + bb;
                y[0] *= sigm(y[0]); y[1] *= sigm(y[1]); y[2] *= sigm(y[2]); y[3] *= sigm(y[3]);
                *(u32x2*)(Y + (size_t)(t0 + tk) * 1280 + 1024 + 4 * lane) = pk4(y); }
        }
    }
}
DI void sgu_phase(LAS unsigned char* lds, const bf16_t* ZC, const LayerW& w, bf16_t* Y) {
    const int TIDX = l_tid(), BIDX = l_bid(), GDIM = l_gdim(); (void)TIDX; (void)BIDX; (void)GDIM;
    LAS bf16_t* VT = (LAS bf16_t*)lds;
    const int tid = TIDX, lane = tid & 63, wid = __builtin_amdgcn_readfirstlane(tid >> 6), qi = lane & 15, gq = lane >> 4;
    for (int chunk = BIDX; chunk < MTOK / 128; chunk += GDIM) {
        const int t0 = chunk * 128;
        __syncthreads();
        {
            const f32x4 gg = *(const f32x4*)(w.sgu_g + 4 * lane), bb = *(const f32x4*)(w.sgu_b + 4 * lane);
            for (int i = 0; i < 16; ++i) { const int tl = wid * 16 + i;
                const u32x2 raw = *(const u32x2*)(ZC + (size_t)(t0 + tl) * 512 + 256 + 4 * lane);
                const f32x4 v = (f32x4){bflo(raw.x), bfhi(raw.x), bflo(raw.y), bfhi(raw.y)};
                float s = (v[0] + v[1]) + (v[2] + v[3]);
#pragma unroll
                for (int o = 32; o >= 1; o >>= 1) s += __shfl_xor(s, o);
                const float mu = s * (1.0f / 256.0f); const f32x4 d = v - mu;
                float q = (d[0] * d[0] + d[1] * d[1]) + (d[2] * d[2] + d[3] * d[3]);
#pragma unroll
                for (int o = 32; o >= 1; o >>= 1) q += __shfl_xor(q, o);
                const float rstd = rsqrtf(q * (1.0f / 256.0f) + 1e-6f);
                const f32x4 y = d * rstd * gg + bb;
                const unsigned p01 = pk2(y[0], y[1]), p23 = pk2(y[2], y[3]);
                VT[(4 * lane + 0) * 136 + tl] = (bf16_t)(p01 & 0xffffu); VT[(4 * lane + 1) * 136 + tl] = (bf16_t)(p01 >> 16);
                VT[(4 * lane + 2) * 136 + tl] = (bf16_t)(p23 & 0xffffu); VT[(4 * lane + 3) * 136 + tl] = (bf16_t)(p23 >> 16); }
        }
        __syncthreads();
        {
            const int nks = (wid >> 1) + 1, t = wid * 16 + qi;
            for (int g = 0; g < 4; ++g) {
                bf16x8 Wf[4];
#pragma unroll
                for (int ks = 0; ks < 4; ++ks) { u32x4 pk = (u32x4){0u, 0u, 0u, 0u};
                    if (ks < nks) { const float* src = w.sgu_w + ((size_t)g * 128 + t) * 128 + 32 * ks + 8 * gq; const f32x4 a = *(const f32x4*)src, b = *(const f32x4*)(src + 4); const int s0 = 32 * ks + 8 * gq;
                        pk.x = pk2(s0 + 0 <= t ? a[0] : 0.f, s0 + 1 <= t ? a[1] : 0.f); pk.y = pk2(s0 + 2 <= t ? a[2] : 0.f, s0 + 3 <= t ? a[3] : 0.f);
                        pk.z = pk2(s0 + 4 <= t ? b[0] : 0.f, s0 + 5 <= t ? b[1] : 0.f); pk.w = pk2(s0 + 6 <= t ? b[2] : 0.f, s0 + 7 <= t ? b[3] : 0.f); }
                    Wf[ks] = __builtin_bit_cast(bf16x8, pk); }
                const float bs = w.sgu_bs[g * 128 + t];
#pragma unroll
                for (int nt = 0; nt < 4; ++nt) {
                    f32x4 acc = (f32x4){0.f, 0.f, 0.f, 0.f};
#pragma unroll
                    for (int ks = 0; ks < 4; ++ks) if (ks < nks) {
                        const bf16x8 vf = *(const LAS bf16x8*)(VT + (g * 64 + 16 * nt + qi) * 136 + 32 * ks + 8 * gq);
                        acc = __builtin_amdgcn_mfma_f32_16x16x32_bf16(vf, Wf[ks], acc, 0, 0, 0); }
                    const int ch = g * 64 + 16 * nt + 4 * gq;
                    const u32x2 ur = *(const u32x2*)(ZC + (size_t)(t0 + t) * 512 + ch);
                    f32x4 o; o[0] = bflo(ur.x) * (acc[0] + bs); o[1] = bfhi(ur.x) * (acc[1] + bs); o[2] = bflo(ur.y) * (acc[2] + bs); o[3] = bfhi(ur.y) * (acc[3] + bs);
                    *(u32x2*)(Y + (size_t)(t0 + t) * 1280 + 768 + ch) = pk4(o);
                }
            }
        }
    }
}
DI void gate_phase(LAS unsigned char* lds, const bf16_t* Q, const float* km, int* cnt, unsigned short* lists) {
    const int TIDX = l_tid(), BIDX = l_bid(), GDIM = l_gdim(); (void)TIDX; (void)BIDX; (void)GDIM;
    LAS float* KM = (LAS float*)lds;
    const int tid = TIDX;
    for (int item = BIDX; item < 512; item += GDIM) {
        const int b = item >> 8, h = (item >> 5) & 7, seg = item & 31;
        __syncthreads();
        { const float* src = km + (size_t)(b * 8 + h) * 4096; *(LAS f32x4*)(KM + tid * 8) = *(const f32x4*)(src + tid * 8); *(LAS f32x4*)(KM + tid * 8 + 4) = *(const f32x4*)(src + tid * 8 + 4); }
        __syncthreads();
        const int t = seg * 512 + tid, blk = t >> 8;
        float qv[64];
        { const bf16_t* qp = Q + ((size_t)(b * SEQ + t)) * 512 + h * 64;
#pragma unroll
          for (int i = 0; i < 8; ++i) { const u32x4 v = *(const u32x4*)(qp + 8 * i); qv[8 * i] = bflo(v.x); qv[8 * i + 1] = bfhi(v.x); qv[8 * i + 2] = bflo(v.y); qv[8 * i + 3] = bfhi(v.y); qv[8 * i + 4] = bflo(v.z); qv[8 * i + 5] = bfhi(v.z); qv[8 * i + 6] = bflo(v.w); qv[8 * i + 7] = bfhi(v.w); } }
        float v0 = -3.0e38f, v1 = -3.0e38f, v2 = -3.0e38f; int i0 = 0, i1 = 0, i2 = 0;
        for (int n = 0; n < blk; ++n) {
            float d0 = 0.f, d1 = 0.f, d2 = 0.f, d3 = 0.f;
#pragma unroll
            for (int d = 0; d < 16; ++d) { const f32x4 kv = *(const LAS f32x4*)(KM + n * 64 + 4 * d); d0 += qv[4 * d] * kv[0]; d1 += qv[4 * d + 1] * kv[1]; d2 += qv[4 * d + 2] * kv[2]; d3 += qv[4 * d + 3] * kv[3]; }
            const float s = (d0 + d1) + (d2 + d3);
            if (s > v0) { v2 = v1; i2 = i1; v1 = v0; i1 = i0; v0 = s; i0 = n; }
            else if (s > v1) { v2 = v1; i2 = i1; v1 = s; i1 = n; }
            else if (s > v2) { v2 = s; i2 = n; }
        }
        const int nv = blk < 3 ? blk : 3; const int lb = (b * 8 + h) * 64;
        if (nv > 0) { const int pos = atomicAdd(cnt + lb + i0, 1); lists[(size_t)(lb + i0) * SEQ + pos] = (unsigned short)((t << 2) | 0); }
        if (nv > 1) { const int pos = atomicAdd(cnt + lb + i1, 1); lists[(size_t)(lb + i1) * SEQ + pos] = (unsigned short)((t << 2) | 1); }
        if (nv > 2) { const int pos = atomicAdd(cnt + lb + i2, 1); lists[(size_t)(lb + i2) * SEQ + pos] = (unsigned short)((t << 2) | 2); }
    }
}
DI void attn_phase(LAS unsigned char* lds, const bf16_t* Q, const bf16_t* K, const bf16_t* V, const unsigned short* lists, const int* cnt, bf16_t* PO, f32x2* ML) {
    const int TIDX = l_tid(), BIDX = l_bid(), GDIM = l_gdim(); (void)TIDX; (void)BIDX; (void)GDIM;
    LAS int* pre = (LAS int*)lds;
    LAS bf16_t* KS = (LAS bf16_t*)(lds + 8192);
    LAS bf16_t* VT = (LAS bf16_t*)(lds + 8192 + 36864);
    const int tid = TIDX, lane = tid & 63, wid = __builtin_amdgcn_readfirstlane(tid >> 6), qi = lane & 15, g = lane >> 4;
    __syncthreads();
    {
        const int a = ((cnt[2 * tid] + 127) >> 7) + 2, b2 = ((cnt[2 * tid + 1] + 127) >> 7) + 2, s = a + b2; int inc = s;
#pragma unroll
        for (int o = 1; o < 64; o <<= 1) { const int v = __shfl_up(inc, o); if (lane >= o) inc += v; }
        if (lane == 63) pre[1032 + wid] = inc;
        __syncthreads();
        int woff = 0; for (int i = 0; i < wid; ++i) woff += pre[1032 + i];
        const int ex = woff + inc - s; pre[2 * tid] = ex; pre[2 * tid + 1] = ex + a; if (tid == 511) pre[1024] = ex + s;
        __syncthreads();
    }
    const int total = pre[1024], per = (total + GDIM - 1) / GDIM;
    const int it0 = BIDX * per, it1 = (it0 + per < total) ? it0 + per : total;
    int curL = -1;
    const float C2 = 0.125f * 1.4426950408889634f;
    for (int it = it0; it < it1; ++it) {
        int lo = 0, hi = 1023; while (lo < hi) { const int mid = (lo + hi + 1) >> 1; if (pre[mid] <= it) lo = mid; else hi = mid - 1; }
        const int L = lo, tile = it - pre[L], cntL = cnt[L], ng = (cntL + 127) >> 7, b = L >> 9, h = (L >> 6) & 7, n = L & 63;
        if (L != curL) {
            __syncthreads();
            { const int key = tid >> 1, part = tid & 1; const bf16_t* src = K + ((size_t)(b * SEQ + n * 256 + key)) * 512 + h * 64 + part * 32;
#pragma unroll
              for (int i = 0; i < 4; ++i) *(LAS u32x4*)(KS + key * 72 + part * 32 + 8 * i) = *(const u32x4*)(src + 8 * i); }
            { const int key = tid & 255, hf = tid >> 8; const bf16_t* src = V + ((size_t)(b * SEQ + n * 256 + key)) * 512 + h * 64 + hf * 32;
#pragma unroll
              for (int i = 0; i < 4; ++i) { const u32x4 v = *(const u32x4*)(src + 8 * i); const int d0 = hf * 32 + 8 * i;
                  VT[(d0 + 0) * 264 + key] = (bf16_t)(v.x & 0xffffu); VT[(d0 + 1) * 264 + key] = (bf16_t)(v.x >> 16); VT[(d0 + 2) * 264 + key] = (bf16_t)(v.y & 0xffffu); VT[(d0 + 3) * 264 + key] = (bf16_t)(v.y >> 16);
                  VT[(d0 + 4) * 264 + key] = (bf16_t)(v.z & 0xffffu); VT[(d0 + 5) * 264 + key] = (bf16_t)(v.z >> 16); VT[(d0 + 6) * 264 + key] = (bf16_t)(v.w & 0xffffu); VT[(d0 + 7) * 264 + key] = (bf16_t)(v.w >> 16); } }
            __syncthreads();
            curL = L;
        }
        const bool causal = tile >= ng; const int to = tile - ng;
        int tq, slot; bool valid = true;
        if (!causal) { const int idx = tile * 128 + wid * 16 + qi; valid = idx < cntL; const unsigned e = valid ? (unsigned)lists[(size_t)L * SEQ + idx] : 0u; tq = (int)(e >> 2); slot = (int)(e & 3u); }
        else { tq = n * 256 + to * 128 + wid * 16 + qi; slot = 3; }
        const size_t tokg = (size_t)b * SEQ + tq;
        const bf16x8 Qf0 = *(const bf16x8*)(Q + tokg * 512 + h * 64 + 8 * g), Qf1 = *(const bf16x8*)(Q + tokg * 512 + h * 64 + 32 + 8 * g);
        const int Tn = causal ? (8 * to + wid + 1) : 16;
        f32x4 sa[16];
#pragma unroll
        for (int T = 0; T < 16; ++T) {
            if (T < Tn) {
                const bf16x8 k0 = *(const LAS bf16x8*)(KS + (16 * T + qi) * 72 + 8 * g), k1 = *(const LAS bf16x8*)(KS + (16 * T + qi) * 72 + 32 + 8 * g);
                f32x4 a = __builtin_amdgcn_mfma_f32_16x16x32_bf16(k0, Qf0, (f32x4){0.f, 0.f, 0.f, 0.f}, 0, 0, 0);
                a = __builtin_amdgcn_mfma_f32_16x16x32_bf16(k1, Qf1, a, 0, 0, 0);
                if (causal && T == Tn - 1) {
#pragma unroll
                    for (int r = 0; r < 4; ++r) if (4 * g + r > qi) a[r] = -1.0e30f; }
                sa[T] = a;
            } else sa[T] = (f32x4){-1.0e30f, -1.0e30f, -1.0e30f, -1.0e30f};
        }
        float mx = -1.0e30f;
#pragma unroll
        for (int T = 0; T < 16; ++T) mx = fmaxf(mx, fmaxf(fmaxf(sa[T][0], sa[T][1]), fmaxf(sa[T][2], sa[T][3])));
        mx = fmaxf(mx, __shfl_xor(mx, 16)); mx = fmaxf(mx, __shfl_xor(mx, 32));
        float ls = 0.f;
#pragma unroll
        for (int T = 0; T < 16; ++T) {
#pragma unroll
            for (int r = 0; r < 4; ++r) { const float pv = __builtin_amdgcn_exp2f((sa[T][r] - mx) * C2); sa[T][r] = pv; ls += pv; } }
        ls += __shfl_xor(ls, 16); ls += __shfl_xor(ls, 32);
        f32x4 oa[4];
#pragma unroll
        for (int dt = 0; dt < 4; ++dt) oa[dt] = (f32x4){0.f, 0.f, 0.f, 0.f};
#pragma unroll
        for (int kp = 0; kp < 8; ++kp) {
            if (2 * kp < Tn) {
                u32x4 pw; pw.x = pk2(sa[2 * kp][0], sa[2 * kp][1]); pw.y = pk2(sa[2 * kp][2], sa[2 * kp][3]); pw.z = pk2(sa[2 * kp + 1][0], sa[2 * kp + 1][1]); pw.w = pk2(sa[2 * kp + 1][2], sa[2 * kp + 1][3]);
                const bf16x8 pf = __builtin_bit_cast(bf16x8, pw);
#pragma unroll
                for (int dt = 0; dt < 4; ++dt) {
                    const s16x4 va = *(const LAS s16x4*)(VT + (16 * dt + qi) * 264 + 32 * kp + 4 * g), vb = *(const LAS s16x4*)(VT + (16 * dt + qi) * 264 + 32 * kp + 16 + 4 * g);
                    const bf16x8 vf = __builtin_shufflevector(va, vb, 0, 1, 2, 3, 4, 5, 6, 7);
                    oa[dt] = __builtin_amdgcn_mfma_f32_16x16x32_bf16(vf, pf, oa[dt], 0, 0, 0);
                }
            }
        }
        if (valid) {
            const float inv = 1.0f / ls; const size_t pidx = (tokg * 8 + h) * 4 + slot;
#pragma unroll
            for (int dt = 0; dt < 4; ++dt) *(u32x2*)(PO + pidx * 64 + 16 * dt + 4 * g) = pk4(oa[dt] * inv);
            if (g == 0) { f32x2 ml; ml.x = mx * C2; ml.y = ls; ML[pidx] = ml; }
        }
    }
}
DI void combine_phase(const bf16_t* PO, const f32x2* ML, bf16_t* Y) {
    const int TIDX = l_tid(), BIDX = l_bid(), GDIM = l_gdim(); (void)TIDX; (void)BIDX; (void)GDIM;
    const size_t gsz = (size_t)GDIM * 512, gid = (size_t)BIDX * 512 + TIDX;
    for (size_t idx = gid; idx < (size_t)MTOK * 64; idx += gsz) {
        const size_t th = idx >> 3; const int part = (int)(idx & 7); const int tok = (int)(th >> 3), h = (int)(th & 7);
        const int blk = (tok & (SEQ - 1)) >> 8, nv = blk < 3 ? blk : 3;
        const f32x4 m01 = *(const f32x4*)(ML + th * 4), m23 = *(const f32x4*)(ML + th * 4 + 2);
        const float m[4] = {m01[0], m01[2], m23[0], m23[2]}, l[4] = {m01[1], m01[3], m23[1], m23[3]};
        float M = m[3];
#pragma unroll
        for (int j = 0; j < 3; ++j) if (j < nv) M = fmaxf(M, m[j]);
        float acc[8], den = 0.f;
#pragma unroll
        for (int i = 0; i < 8; ++i) acc[i] = 0.f;
#pragma unroll
        for (int j = 0; j < 4; ++j) if (j == 3 || j < nv) {
            const float wgt = l[j] * __builtin_amdgcn_exp2f(m[j] - M); den += wgt;
            const u32x4 v = *(const u32x4*)(PO + (th * 4 + j) * 64 + part * 8);
            acc[0] += wgt * bflo(v.x); acc[1] += wgt * bfhi(v.x); acc[2] += wgt * bflo(v.y); acc[3] += wgt * bfhi(v.y); acc[4] += wgt * bflo(v.z); acc[5] += wgt * bfhi(v.z); acc[6] += wgt * bflo(v.w); acc[7] += wgt * bfhi(v.w);
        }
        const float inv = 1.0f / den;
        u32x4 o; o.x = pk2(acc[0] * inv, acc[1] * inv); o.y = pk2(acc[2] * inv, acc[3] * inv); o.z = pk2(acc[4] * inv, acc[5] * inv); o.w = pk2(acc[6] * inv, acc[7] * inv);
        *(u32x4*)(Y + (size_t)tok * 1280 + 256 + h * 64 + part * 8) = o;
    }
}
DI void final_phase(float* X, const float* ss, const float* g) {
    const int TIDX = l_tid(), BIDX = l_bid(), GDIM = l_gdim(); (void)TIDX; (void)BIDX; (void)GDIM;
    const size_t gsz = (size_t)GDIM * 512, gid = (size_t)BIDX * 512 + TIDX;
    for (size_t i = gid; i < (size_t)MTOK * 256; i += gsz) {
        const int row = (int)(i >> 8), c4 = (int)(i & 255) * 4;
        const float rs = rsqrtf(ss[row] * (1.0f / 1024.0f) + 1e-6f);
        const f32x4 v = *(const f32x4*)(X + i * 4), gg = *(const f32x4*)(g + c4);
        *(f32x4*)(X + i * 4) = v * rs * gg;
    }
}

typedef const __attribute__((address_space(4))) Params* KParams;
DI Params kparams() { KParams kp = (KParams)__builtin_amdgcn_kernarg_segment_ptr(); asm volatile("" : "+s"(kp)); Params p;
#pragma unroll
    for (int i = 0; i < 25; ++i) p.in[i] = kp->in[i];
    p.out = kp->out; p.ws = kp->ws; return p; }
#define WSP(T, off) ((T*)(p.ws + (off)))
__global__ void __launch_bounds__(512, 2) fwd_mega(Params p_unused) {
    extern __shared__ __attribute__((aligned(16))) unsigned char lds_raw[];
    LAS unsigned char* lds = (LAS unsigned char*)lds_raw;
    cg::grid_group grid = cg::this_grid();
#ifndef SK_P0
    { const Params p = kparams(); prep_weights(p, (LAS float*)lds, WSP(bf16_t, WS_WTS)); }
    { const Params p = kparams(); phase0_misc(p, WSP(bf16_t, WS_XB), WSP(float, WS_MISC + MISC_SS), WSP(float, WS_ROPE), WSP(int, WS_MISC + MISC_CNT)); }
#endif
    grid.sync();
    for (int l = 0; l < 2; ++l) {
#ifndef SK_G1
        { const Params p = kparams(); pg8::Sched<0, 11, 1024, 1024, 16> S{l_gdim(), l_bid()};
          EpiIn E{p.ws, 2 * l};
          pg8::gemm_phase(lds, WSP(bf16_t, WS_XB), WSP(bf16_t, WS_WTS) + (size_t)l * W_LAYER + W_IN, S, E); }
#endif
        grid.sync();
#ifndef SK_KM
        { const Params p = kparams(); kmean_phase(WSP(bf16_t, WS_R + R_K), WSP(float, WS_MISC + MISC_KM)); }
#endif
#ifndef SK_POOL
        { const Params p = kparams(); pool_phase(WSP(bf16_t, WS_R + R_XA), WSP(bf16_t, WS_Y)); }
#endif
#ifndef SK_CONV
        { const Params p = kparams(); const LayerW w = layer_w(p, l); conv_phase(lds, WSP(bf16_t, WS_R + R_H), w, WSP(bf16_t, WS_Y)); }
#endif
#ifndef SK_SGU
        { const Params p = kparams(); const LayerW w = layer_w(p, l); sgu_phase(lds, WSP(bf16_t, WS_R + R_ZC), w, WSP(bf16_t, WS_Y)); }
#endif
        grid.sync();
#ifndef SK_GATE
        { const Params p = kparams(); gate_phase(lds, WSP(bf16_t, WS_R + R_Q), WSP(float, WS_MISC + MISC_KM), WSP(int, WS_MISC + MISC_CNT) + l * 1024, WSP(unsigned short, WS_R + R_LISTS)); }
#endif
        grid.sync();
#ifndef SK_ATT
        { const Params p = kparams(); attn_phase(lds, WSP(bf16_t, WS_R + R_Q), WSP(bf16_t, WS_R + R_K), WSP(bf16_t, WS_R + R_V), WSP(unsigned short, WS_R + R_LISTS), WSP(int, WS_MISC + MISC_CNT) + l * 1024, WSP(bf16_t, WS_R + R_PO), WSP(f32x2, WS_R + R_ML)); }
#endif
        grid.sync();
#ifndef SK_COMB
        { const Params p = kparams(); combine_phase(WSP(bf16_t, WS_R + R_PO), WSP(f32x2, WS_R + R_ML), WSP(bf16_t, WS_Y)); }
#endif
        grid.sync();
#ifndef SK_P3
        { const Params p = kparams(); pg8::Sched<1, 16, 1280, 1280, 4> S{l_gdim(), l_bid()}; EpiProj E{WSP(bf16_t, WS_R)};
          pg8::gemm_phase(lds, WSP(bf16_t, WS_Y), WSP(bf16_t, WS_WTS) + (size_t)l * W_LAYER + W_P, S, E); }
#endif
        grid.sync();
#ifndef SK_P4
        { const Params p = kparams(); pg8::Sched<0, 16, 1024, 1024, 16> S{l_gdim(), l_bid()};
          EpiGate E{WSP(float, WS_MISC + MISC_SS) + (size_t)(2 * l) * MTOK, p.in[5] + (size_t)l * 4096, WSP(bf16_t, WS_R), WSP(bf16_t, WS_Y)};
          pg8::gemm_phase(lds, WSP(bf16_t, WS_XB), WSP(bf16_t, WS_WTS) + (size_t)l * W_LAYER + W_G, S, E); }
#endif
        grid.sync();
#ifndef SK_P5
        { const Params p = kparams(); pg8::Sched<0, 4, 1024, 1024, 16> S{l_gdim(), l_bid()};
          EpiRes E{l == 0 ? p.in[0] : p.out, p.out, WSP(bf16_t, WS_XB), WSP(float, WS_MISC + MISC_SS) + (size_t)(2 * l + 1) * MTOK};
          pg8::gemm_phase(lds, WSP(bf16_t, WS_Y), WSP(bf16_t, WS_WTS) + (size_t)l * W_LAYER + W_O, S, E); }
#endif
        grid.sync();
#ifndef SK_P6
        { const Params p = kparams(); pg8::Sched<0, 22, 1024, 1024, 16> S{l_gdim(), l_bid()};
          EpiSwi E{WSP(float, WS_MISC + MISC_SS) + (size_t)(2 * l + 1) * MTOK, WSP(bf16_t, WS_R)};
          pg8::gemm_phase(lds, WSP(bf16_t, WS_XB), WSP(bf16_t, WS_WTS) + (size_t)l * W_LAYER + W_F1, S, E); }
#endif
        grid.sync();
#ifndef SK_P7
        { const Params p = kparams(); pg8::Sched<0, 4, 2816, 2816, 44> S{l_gdim(), l_bid()};
          EpiRes E{p.out, p.out, WSP(bf16_t, WS_XB), WSP(float, WS_MISC + MISC_SS) + (size_t)(2 * l + 2) * MTOK};
          pg8::gemm_phase(lds, WSP(bf16_t, WS_R), WSP(bf16_t, WS_WTS) + (size_t)l * W_LAYER + W_F2, S, E); }
#endif
        grid.sync();
    }
    { const Params p = kparams(); final_phase(p.out, WSP(float, WS_MISC + MISC_SS) + (size_t)4 * MTOK, p.in[24]); }
}

extern "C" void kernel_launch(void* const* d_in, const int* in_sizes, int n_in, void* d_out, int out_size, void* d_ws, size_t ws_size, hipStream_t stream) {
    static int grid = 0;
    if (grid == 0) {
        int dev = 0, cus = 0, per_cu = 0;
        if (n_in != 25 || out_size != MTOK * DM || ws_size < WS_END) { fprintf(stderr, "kernel_launch: unexpected shapes / workspace (n_in %d out %d ws %zu)\n", n_in, out_size, ws_size); grid = -1; return; }
        (void)hipGetDevice(&dev); (void)hipDeviceGetAttribute(&cus, hipDeviceAttributeMultiprocessorCount, dev);
        (void)hipFuncSetAttribute((const void*)fwd_mega, hipFuncAttributeMaxDynamicSharedMemorySize, LDS_BYTES);
        (void)hipOccupancyMaxActiveBlocksPerMultiprocessor(&per_cu, (const void*)fwd_mega, 512, LDS_BYTES);
        grid = cus > 0 ? cus : 256;
    }
    if (grid < 0) return;
    Params p{};
    for (int i = 0; i < 25; ++i) p.in[i] = (const float*)d_in[i];
    p.out = (float*)d_out; p.ws = (unsigned char*)d_ws;
    void* args[] = {&p};
    hipError_t e = hipLaunchCooperativeKernel((const void*)fwd_mega, dim3(grid), dim3(512), args, LDS_BYTES, stream);
    if (e != hipSuccess) fprintf(stderr, "cooperative launch failed: %s (grid %d)\n", hipGetErrorString(e), grid);
}
```

```cpp
#include <hip/hip_runtime.h>
#include <hip/hip_cooperative_groups.h>
#include <cstdio>
namespace cg = cooperative_groups;
#define LAS __attribute__((address_space(3)))
#define DI __device__ __forceinline__
typedef unsigned short bf16_t;
typedef short bf16x8 __attribute__((ext_vector_type(8)));
typedef short s16x4 __attribute__((ext_vector_type(4)));
typedef float f32x4 __attribute__((ext_vector_type(4)));
typedef float f32x2 __attribute__((ext_vector_type(2)));
typedef unsigned u32x4 __attribute__((ext_vector_type(4)));
typedef unsigned u32x2 __attribute__((ext_vector_type(2)));

constexpr int SEQ = 16384, MTOK = 32768, DM = 1024, NIN = 2816, FF = 2816;
constexpr int LDS_BYTES = 131072 + 64 + 11264;
constexpr size_t MiB = 1048576;
constexpr size_t WS_XB = 0, WS_WTS = 64 * MiB, WS_ROPE = 140 * MiB, WS_MISC = 148 * MiB, WS_Y = 150 * MiB, WS_R = 230 * MiB, WS_SSP = 494 * MiB, WS_END = 496 * MiB;
constexpr size_t R_Q = 0, R_K = 32 * MiB, R_V = 64 * MiB, R_LISTS = 96 * MiB, R_ML = 128 * MiB, R_XA = 136 * MiB, R_ZC = 152 * MiB, R_H = 184 * MiB, R_PO = 136 * MiB;
constexpr size_t W_IN = 0, W_G = W_IN + (size_t)2816 * 1024, W_P = W_G + (size_t)4096 * 1024, W_O = W_P + (size_t)1024 * 1280, W_F1 = W_O + (size_t)1024 * 1024, W_F2 = W_F1 + (size_t)5632 * 1024, W_LAYER = W_F2 + (size_t)1024 * 2816;
constexpr size_t MISC_SS = 0, MISC_KM = 5 * (size_t)MTOK * 4, MISC_CNT = MISC_KM + 1024 * 64 * 4, MISC_BAR = MISC_CNT + 2048 * 4;

DI unsigned pk2(float lo, float hi) { unsigned r; asm volatile("v_cvt_pk_bf16_f32 %0, %1, %2" : "=v"(r) : "v"(lo), "v"(hi)); return r; }
DI float bflo(unsigned u) { return __uint_as_float(u << 16); }
DI float bfhi(unsigned u) { return __uint_as_float(u & 0xffff0000u); }
DI float bf1(bf16_t u) { return __uint_as_float(((unsigned)u) << 16); }
DI float sigm(float z) { return __builtin_amdgcn_rcpf(1.0f + __expf(-z)); }
DI float gelu_t(float x) { return x * sigm(1.5957691216057308f * (x + 0.044715f * x * x * x)); }
DI u32x2 pk4(f32x4 v) { u32x2 w; w.x = pk2(v[0], v[1]); w.y = pk2(v[2], v[3]); return w; }

DI int l_tid() { int t = threadIdx.x; asm volatile("" : "+v"(t)); return t; }
DI int l_bid() { int b = blockIdx.x; asm volatile("" : "+s"(b)); return b; }
DI int l_gdim() { int b = gridDim.x; asm volatile("" : "+s"(b)); return b; }
DI float row_rs(const unsigned long long* ssp, int row) { return rsqrtf((float)ssp[row] * (1.0f / (1048576.0f * 1024.0f)) + 1e-6f); }
DI unsigned long long ss_fix(float sq) { return (unsigned long long)(sq * 1048576.0f + 0.5f); }
struct Params { const float* in[25]; float* out; unsigned char* ws; };

namespace pg8 {
constexpr int BM = 256, BK = 64, HALF = 128, HTB = HALF * BK * 2, STAGE_BYTES = 8 * HTB, NXCD = 8, WGM = 8;
DI int lds_byte(int r, int c) { const int st = (r >> 4) * 2 + (c >> 5), rr = r & 15, cc = c & 31, ob = rr * 64 + cc * 2; return st * 1024 + (ob ^ (((ob >> 9) & 1) << 5)); }
DI void stage_rc(int b, int& R, int& C) { const int st = b / 1024, sb = b % 1024, swz = sb ^ (((sb >> 9) & 1) << 5); R = (st >> 1) * 16 + swz / 64; C = (st & 1) * 32 + (swz % 64) / 2; }
DI int perm32(int rho) { const int n = rho >> 4, i = rho & 15; return 8 * (i >> 2) + 4 * n + (i & 3); }
struct Unit { int pm, pn, nt, aux; size_t aoff, boff; };
template <int MODE, int NN, int LDA, int LDB, int NT0, int NM = MTOK / 256, int PM0 = 0>
struct Sched {
    static constexpr int nM = NM, nN = NN, nwg = nM * nN, lda = LDA, ldb = LDB;
    int G, c;
    DI bool next(int i, Unit& u) const {
        const int L = i * G + c; if (L >= nwg) return false;
        int wgid = L; { constexpr int q = nwg / NXCD; const int xcd = wgid % NXCD, off = wgid / NXCD; wgid = xcd * q + off; }
        constexpr int nig = WGM * nN; const int gid = wgid / nig, fm = gid * WGM;
        const int pm = PM0 + fm + ((wgid % nig) % WGM), pn = (wgid % nig) / WGM;
        u.pm = pm;
        if (MODE == 0) { u.pn = pn; u.aux = 0; u.nt = NT0; u.aoff = (size_t)pm * BM * lda * 2; u.boff = (size_t)pn * BM * ldb * 2; }
        else { const int br = pn >> 2, pi = pn & 3; const int koff = br == 0 ? 0 : (br == 1 ? 256 : (br == 2 ? 768 : 1024));
               u.pn = pi; u.aux = br; u.nt = br == 1 ? 8 : 4; u.aoff = ((size_t)pm * BM * lda + koff) * 2; u.boff = ((size_t)pi * BM * ldb + koff) * 2; }
        return true;
    }
};

template <class Epi, class SchedT>
DI void gemm_phase(LAS unsigned char* lds, const bf16_t* A, const bf16_t* Bt, const SchedT& S, const Epi& E) {
    const int tid = l_tid(), wid = __builtin_amdgcn_readfirstlane(tid >> 6), lane = tid & 63, wr = wid >> 2, wc = wid & 3, fr = lane & 15, fq = lane >> 4;
    constexpr int lda = SchedT::lda, ldb = SchedT::ldb;
    unsigned voffA[2], voffB[2];
#pragma unroll
    for (int i = 0; i < 2; ++i) { int R, C; stage_rc(tid * 16 + i * 8192, R, C); const int Rb = Epi::PERM ? ((R & ~31) + perm32(R & 31)) : R;
        voffA[i] = (unsigned)(R * lda + C) * 2u; voffB[i] = (unsigned)(Rb * ldb + C) * 2u; }
    const size_t kstep = (size_t)(BK * 2);
    const size_t hstepA = (size_t)HALF * lda * 2, hstepB = (size_t)HALF * ldb * 2;
    const unsigned ldsw = (unsigned)wid * 1024u;
    const int aoff = lds_byte(wr * 64 + fr, fq * 8), boff = lds_byte(wc * 32 + fr, fq * 8);
#define PG8_SA(b, h) (((b) * 2 + (h)) * HTB)
#define PG8_SB(b, h) ((4 + (b) * 2 + (h)) * HTB)
#define PG8_STAGE(bufoff, gbase, voff) do { _Pragma("unroll") for (int _i = 0; _i < 2; ++_i) \
        __builtin_amdgcn_global_load_lds((const unsigned*)((const char*)(gbase) + (voff)[_i]), (LAS unsigned*)(lds + (bufoff) + ldsw + _i * 8192), 16, 0, 0); } while (0)
#define PG8_LDA(dst, b, h) do { _Pragma("unroll") for (int m = 0; m < 4; ++m) _Pragma("unroll") for (int k = 0; k < 2; ++k) dst[m][k] = *(const LAS bf16x8*)(lds + PG8_SA(b, h) + aoff + m * 2048 + k * 1024); } while (0)
#define PG8_LDB(dst, b, h) do { _Pragma("unroll") for (int n = 0; n < 2; ++n) _Pragma("unroll") for (int k = 0; k < 2; ++k) dst[n][k] = *(const LAS bf16x8*)(lds + PG8_SB(b, h) + boff + n * 2048 + k * 1024); } while (0)
#define PG8_MMA(ai, bj, At, Bt_) do { __builtin_amdgcn_s_setprio(1); _Pragma("unroll") for (int m = 0; m < 4; ++m) _Pragma("unroll") for (int n = 0; n < 2; ++n) _Pragma("unroll") for (int k = 0; k < 2; ++k) \
        acc[ai][bj][m][n] = __builtin_amdgcn_mfma_f32_16x16x32_bf16(Bt_[n][k], At[m][k], acc[ai][bj][m][n], 0, 0, 0); __builtin_amdgcn_s_setprio(0); } while (0)
#define PG8_WAIT_V(n) asm volatile("s_waitcnt vmcnt(" #n ")" ::: "memory")
#define PG8_WAIT_L(n) asm volatile("s_waitcnt lgkmcnt(" #n ")" ::: "memory")
#define PG8_BAR __builtin_amdgcn_s_barrier()
#define PG8_SCHED __builtin_amdgcn_sched_barrier(0)
    Unit cur, nxt; int ui = 0;
    if (!S.next(0, cur)) return;
    LAS float* rsl = (LAS float*)(lds + 131072 + 64);
    if constexpr (Epi::RS) {
        for (int i = 0; i < 11; ++i) { Unit uu; if (!S.next(i, uu)) break; if (tid < 256) rsl[i * 256 + tid] = row_rs(E.ss, uu.pm * 256 + tid); }
        __syncthreads();
    }
    f32x4 acc[2][2][4][2];
#pragma unroll
    for (int a = 0; a < 2; ++a)
#pragma unroll
        for (int b = 0; b < 2; ++b)
#pragma unroll
            for (int m = 0; m < 4; ++m)
#pragma unroll
                for (int n = 0; n < 2; ++n) acc[a][b][m][n] = (f32x4){0.f, 0.f, 0.f, 0.f};
    bf16x8 At[4][2], B0[2][2], B1[2][2];
    const char* cA = (const char*)A + cur.aoff; const char* cB = (const char*)Bt + cur.boff;
    PG8_STAGE(PG8_SB(0, 0), cB, voffB); PG8_STAGE(PG8_SA(0, 0), cA, voffA); PG8_STAGE(PG8_SB(0, 1), cB + hstepB, voffB); PG8_STAGE(PG8_SA(0, 1), cA + hstepA, voffA);
    if (wr == 1) PG8_BAR;
    PG8_WAIT_V(4); PG8_BAR;
    PG8_STAGE(PG8_SB(1, 0), cB + kstep, voffB); PG8_STAGE(PG8_SA(1, 0), cA + kstep, voffA); PG8_STAGE(PG8_SB(1, 1), cB + hstepB + kstep, voffB);
    PG8_WAIT_V(6); PG8_BAR;
    for (;;) {
        const bool has_next = S.next(ui + 1, nxt);
        const char* nA = has_next ? (const char*)A + nxt.aoff : cA; const char* nB = has_next ? (const char*)Bt + nxt.boff : cB;
        const int nt = cur.nt;
        for (int t = 0; t < nt; t += 2) {
            const bool last = (t == nt - 2);
            const char* a1 = cA + (size_t)(t + 1) * kstep;
            const char* a2 = last ? nA : cA + (size_t)(t + 2) * kstep; const char* b2 = last ? nB : cB + (size_t)(t + 2) * kstep;
            const char* a3 = a2 + kstep; const char* b3 = b2 + kstep;
            PG8_LDB(B0, 0, 0); PG8_SCHED; PG8_LDA(At, 0, 0); PG8_STAGE(PG8_SA(1, 1), a1 + hstepA, voffA);
            PG8_WAIT_L(8); PG8_BAR; PG8_WAIT_L(0); PG8_MMA(0, 0, At, B0); PG8_BAR; PG8_SCHED;
            PG8_LDB(B1, 0, 1); PG8_STAGE(PG8_SB(0, 0), b2, voffB);
            PG8_BAR; PG8_WAIT_L(0); PG8_MMA(0, 1, At, B1); PG8_BAR;
            PG8_LDA(At, 0, 1); PG8_STAGE(PG8_SA(0, 0), a2, voffA);
            PG8_BAR; PG8_WAIT_L(0); PG8_MMA(1, 0, At, B0); PG8_BAR; PG8_SCHED;
            PG8_STAGE(PG8_SB(0, 1), b2 + hstepB, voffB);
            PG8_WAIT_V(6); PG8_BAR; PG8_MMA(1, 1, At, B1); PG8_BAR;
            PG8_LDB(B0, 1, 0); PG8_SCHED; PG8_LDA(At, 1, 0); PG8_STAGE(PG8_SA(0, 1), a2 + hstepA, voffA);
            PG8_WAIT_L(8); PG8_BAR; PG8_WAIT_L(0); PG8_MMA(0, 0, At, B0); PG8_BAR; PG8_SCHED;
            PG8_LDB(B1, 1, 1); PG8_STAGE(PG8_SB(1, 0), b3, voffB);
            PG8_BAR; PG8_WAIT_L(0); PG8_MMA(0, 1, At, B1); PG8_BAR;
            PG8_LDA(At, 1, 1); PG8_STAGE(PG8_SA(1, 0), a3, voffA);
            PG8_BAR; PG8_WAIT_L(0); PG8_MMA(1, 0, At, B0); PG8_BAR; PG8_SCHED;
            PG8_STAGE(PG8_SB(1, 1), b3 + hstepB, voffB);
            PG8_WAIT_V(6); PG8_BAR; PG8_MMA(1, 1, At, B1); PG8_BAR;
        }
        E(acc, cur, wr, wc, fr, fq, rsl + ui * 256);
        if (!has_next) break;
#pragma unroll
        for (int a = 0; a < 2; ++a)
#pragma unroll
            for (int b = 0; b < 2; ++b)
#pragma unroll
                for (int m = 0; m < 4; ++m)
#pragma unroll
                    for (int n = 0; n < 2; ++n) acc[a][b][m][n] = (f32x4){0.f, 0.f, 0.f, 0.f};
        cur = nxt; cA = nA; cB = nB; ++ui;
    }
    PG8_WAIT_V(0);
    if (wr == 0) PG8_BAR;
    PG8_BAR;
#undef PG8_SA
#undef PG8_SB
#undef PG8_STAGE
#undef PG8_LDA
#undef PG8_LDB
#undef PG8_MMA
#undef PG8_WAIT_V
#undef PG8_WAIT_L
#undef PG8_BAR
#undef PG8_SCHED
}
}
using pg8::Unit;
typedef const f32x4 (&AccRef)[2][2][4][2];

#define XB_TMO      128
#define XB_XCNT(j)  (256  + 64 * (j))
#define XB_XSUB(j)  (1280 + 64 * (j))
#define XB_XGEN(j)  (2304 + 64 * (j))
#define XB_TOP      3328
#define XB_TOPGEN   3392
#define XCD_BAR_WORDS 3456
#define XB_SPIN_CAP (1u << 22)
DI unsigned xb_ld(unsigned* p)              { return __hip_atomic_load(p, __ATOMIC_RELAXED, __HIP_MEMORY_SCOPE_AGENT); }
DI unsigned xb_add(unsigned* p, unsigned v) { return __hip_atomic_fetch_add(p, v, __ATOMIC_RELAXED, __HIP_MEMORY_SCOPE_AGENT); }
DI unsigned xb_xcc_id() { return (unsigned)__builtin_amdgcn_s_getreg((3 << 11) | 20) & 0xFu; }
#define XB_SPIN(cond, bar) do { unsigned _sp = 0; while (cond) { __builtin_amdgcn_s_sleep(1); \
    if ((++_sp & 255u) == 0u) { if (xb_ld(&(bar)[XB_TMO])) break; if (_sp > XB_SPIN_CAP) { atomicAdd(&(bar)[XB_TMO], 1u); break; } } } } while (0)
DI void xcd_barrier_post(unsigned* bar) { if (threadIdx.x == 0) (void)xb_add(&bar[XB_XCNT(xb_xcc_id())], 1u); }
DI void xcd_barrier_complete(unsigned* bar, unsigned x, unsigned& nloc, unsigned& nx) {
    const unsigned G = gridDim.x;
    unsigned sum, cnt, mine, sp = 0u;
    for (;;) {
        sum = 0u; cnt = 0u; mine = 0u;
#pragma unroll
        for (unsigned j = 0; j < 16; ++j) { const unsigned c = xb_ld(&bar[XB_XCNT(j)]); sum += c; cnt += (c > 0u) ? 1u : 0u; mine = (j == x) ? c : mine; }
        if (sum == G) break;
        __builtin_amdgcn_s_sleep(1);
        if ((++sp & 255u) == 0u) { if (xb_ld(&bar[XB_TMO])) break; if (sp > XB_SPIN_CAP) { atomicAdd(&bar[XB_TMO], 1u); break; } }
    }
    nloc = mine > 0u ? mine : 1u; nx = cnt > 0u ? cnt : 1u;
}
DI void xcd_barrier(unsigned* bar, volatile LAS unsigned* st) {
    asm volatile("s_waitcnt vmcnt(0)" ::: "memory");
    __syncthreads();
    if (threadIdx.x == 0) {
        const unsigned x = xb_xcc_id();
        __builtin_amdgcn_s_waitcnt(0);
        unsigned nloc = st[0], nx = st[1];
        if (nloc == 0u) { xcd_barrier_complete(bar, x, nloc, nx); st[0] = nloc; st[1] = nx; }
        const unsigned old = xb_add(&bar[XB_XSUB(x)], 1u);
        const unsigned gen = old / nloc;
        if (old + 1u == (gen + 1u) * nloc) {
            __builtin_amdgcn_fence(__ATOMIC_RELEASE, "agent");
            asm volatile("s_waitcnt vmcnt(0)" ::: "memory");
            const unsigned og = xb_add(&bar[XB_TOP], 1u);
            const unsigned tg = og / nx;
            if (og + 1u == (tg + 1u) * nx) xb_add(&bar[XB_TOPGEN], 1u);
            else XB_SPIN(xb_ld(&bar[XB_TOPGEN]) == tg, bar);
            __builtin_amdgcn_fence(__ATOMIC_ACQUIRE, "agent");
            xb_add(&bar[XB_XGEN(x)], 1u);
            asm volatile("s_waitcnt vmcnt(0)" ::: "memory");
        } else {
            XB_SPIN(xb_ld(&bar[XB_XGEN(x)]) == gen, bar);
            __builtin_amdgcn_fence(__ATOMIC_ACQUIRE, "agent");
            asm volatile("s_waitcnt vmcnt(0)" ::: "memory");
        }
    }
    __syncthreads();
}
struct EpiIn {
    static constexpr bool PERM = true; static constexpr bool RS = true; static constexpr int NST = 16;
    unsigned char* ws; int ssi; const unsigned long long* ss;
    template <int TY> DI void run(AccRef acc, const Unit& u, int wr, int wc, int fr, int fq, const LAS float* rsl) const {
        const int pn = u.pn;
        const float* rope = (const float*)(ws + WS_ROPE);
        bf16_t* XA = (bf16_t*)(ws + WS_R + R_XA); bf16_t* Q = (bf16_t*)(ws + WS_R + R_Q); bf16_t* K = (bf16_t*)(ws + WS_R + R_K); bf16_t* V = (bf16_t*)(ws + WS_R + R_V);
        bf16_t* ZC = (bf16_t*)(ws + WS_R + R_ZC); bf16_t* H = (bf16_t*)(ws + WS_R + R_H);
        float rsv[2][4];
#pragma unroll
        for (int ai = 0; ai < 2; ++ai)
#pragma unroll
            for (int m = 0; m < 4; ++m) rsv[ai][m] = rsl[ai * 128 + wr * 64 + m * 16 + fr];
#pragma unroll
        for (int ai = 0; ai < 2; ++ai) {
          f32x4 rp[4][2][2];
          if (TY == 2) {
#pragma unroll
            for (int m = 0; m < 4; ++m)
#pragma unroll
                for (int w2 = 0; w2 < 1; ++w2) { const float* rb = rope + ((size_t)(u.pm * 256 + ai * 128 + wr * 64 + m * 16 + fr) * 32 + 16 * (wc & 1) + 4 * fq) * 2;
                    rp[m][0][0] = *(const f32x4*)rb; rp[m][0][1] = *(const f32x4*)(rb + 4); rp[m][1][0] = rp[m][0][0]; rp[m][1][1] = rp[m][0][1]; }
          }
#pragma unroll
            for (int m = 0; m < 4; ++m) {
                const int row = u.pm * 256 + ai * 128 + wr * 64 + m * 16 + fr;
                const float rs = rsv[ai][m];
#pragma unroll
                for (int bj = 0; bj < 2; ++bj) {
                    const f32x4 v0 = acc[ai][bj][m][0] * rs, v1 = acc[ai][bj][m][1] * rs;
                    if (TY == 0) {
                        bf16_t* dst; int ld, cb;
                        if (pn == 0) { dst = XA; ld = 256; cb = 0; } else { dst = V; ld = 512; cb = (pn - 5) * 256; }
                        u32x4 w; w.x = pk2(v0[0], v0[1]); w.y = pk2(v0[2], v0[3]); w.z = pk2(v1[0], v1[1]); w.w = pk2(v1[2], v1[3]);
                        *(u32x4*)(dst + (size_t)row * ld + cb + bj * 128 + wc * 32 + 8 * fq) = w;
                    } else if (TY == 1) {
                        u32x4 w; w.x = pk2(gelu_t(v0[0]), gelu_t(v0[1])); w.y = pk2(gelu_t(v0[2]), gelu_t(v0[3])); w.z = pk2(gelu_t(v1[0]), gelu_t(v1[1])); w.w = pk2(gelu_t(v1[2]), gelu_t(v1[3]));
                        *(u32x4*)(ZC + (size_t)row * 512 + (pn - 7) * 256 + bj * 128 + wc * 32 + 8 * fq) = w;
                    } else if (TY == 2) {
                        bf16_t* dst = pn >= 3 ? K : Q; const int hb = ((pn - 1) & 1) * 4 + bj * 2 + (wc >> 1); const int idx = 16 * (wc & 1) + 4 * fq;
                        const f32x4 r0 = rp[m][bj][0], r1 = rp[m][bj][1];
                        f32x4 o1, o2;
                        o1[0] = v0[0] * r0[0] - v1[0] * r0[1]; o2[0] = v1[0] * r0[0] + v0[0] * r0[1];
                        o1[1] = v0[1] * r0[2] - v1[1] * r0[3]; o2[1] = v1[1] * r0[2] + v0[1] * r0[3];
                        o1[2] = v0[2] * r1[0] - v1[2] * r1[1]; o2[2] = v1[2] * r1[0] + v0[2] * r1[1];
                        o1[3] = v0[3] * r1[2] - v1[3] * r1[3]; o2[3] = v1[3] * r1[2] + v0[3] * r1[3];
                        bf16_t* p = dst + (size_t)row * 512 + hb * 64 + idx;
                        *(u32x2*)p = pk4(o1); *(u32x2*)(p + 32) = pk4(o2);
                    } else {
                        const int blk = (pn - 9) * 4 + bj * 2 + (wc >> 1); const int idx = 32 * blk + 16 * (wc & 1) + 4 * fq;
                        f32x4 o; o[0] = v0[0] * sigm(v1[0]); o[1] = v0[1] * sigm(v1[1]); o[2] = v0[2] * sigm(v1[2]); o[3] = v0[3] * sigm(v1[3]);
                        *(u32x2*)(H + (size_t)row * 256 + idx) = pk4(o);
                    }
                }
            }
        }
    }
    DI void operator()(AccRef acc, const Unit& u, int wr, int wc, int fr, int fq, const LAS float* rsl) const {
        const int pn = u.pn;
        if (pn == 0 || pn == 5 || pn == 6) run<0>(acc, u, wr, wc, fr, fq, rsl);
        else if (pn == 7 || pn == 8) run<1>(acc, u, wr, wc, fr, fq, rsl);
        else if (pn <= 4) run<2>(acc, u, wr, wc, fr, fq, rsl);
        else run<3>(acc, u, wr, wc, fr, fq, rsl);
    }
};
struct EpiProj {
    static constexpr bool PERM = true; static constexpr bool RS = false; static constexpr int NST = 16;
    bf16_t* P;
    DI void operator()(AccRef acc, const Unit& u, int wr, int wc, int fr, int fq, const LAS float* rsl) const {
        const int br = u.aux;
#pragma unroll
        for (int ai = 0; ai < 2; ++ai)
#pragma unroll
            for (int m = 0; m < 4; ++m) {
                const int row = u.pm * 256 + ai * 128 + wr * 64 + m * 16 + fr;
#pragma unroll
                for (int bj = 0; bj < 2; ++bj) {
                    const f32x4 v0 = acc[ai][bj][m][0], v1 = acc[ai][bj][m][1];
                    u32x4 w; w.x = pk2(v0[0], v0[1]); w.y = pk2(v0[2], v0[3]); w.z = pk2(v1[0], v1[1]); w.w = pk2(v1[2], v1[3]);
                    *(u32x4*)(P + (size_t)row * 4096 + br * 1024 + u.pn * 256 + wc * 64 + bj * 32 + 8 * fq) = w;
                }
            }
    }
};
struct EpiGate {
    static constexpr bool PERM = true; static constexpr bool RS = false; static constexpr int NST = 8;
    const unsigned long long* ss; const float* bg; const bf16_t* P; bf16_t* MG;
    DI void operator()(AccRef acc, const Unit& u, int wr, int wc, int fr, int fq, const LAS float* rsl) const {
        const int oc = u.pn * 64 + 16 * wc + 4 * fq;
        const int ocp = (oc & ~255) + ((oc >> 5) & 3) * 64 + ((oc >> 7) & 1) * 32 + (oc & 31);
        float rsv[2][4];
#pragma unroll
        for (int ai = 0; ai < 2; ++ai)
#pragma unroll
            for (int m = 0; m < 4; ++m) rsv[ai][m] = row_rs(ss, u.pm * 256 + ai * 128 + wr * 64 + m * 16 + fr);
        f32x4 bv[2][2];
#pragma unroll
        for (int bj = 0; bj < 2; ++bj)
#pragma unroll
            for (int n = 0; n < 2; ++n) bv[bj][n] = *(const f32x4*)(bg + (2 * bj + n) * 1024 + oc);
#define GATE_PLOAD(dst, ai_, m_) do { _Pragma("unroll") for (int bj = 0; bj < 2; ++bj) { const bf16_t* pp = P + (size_t)(u.pm * 256 + (ai_) * 128 + wr * 64 + (m_) * 16 + fr) * 4096 + (2 * bj) * 1024 + ocp; \
            const u32x2 q0 = *(const u32x2*)pp, q1 = *(const u32x2*)(pp + 1024); dst[bj] = (u32x4){q0.x, q0.y, q1.x, q1.y}; } } while (0)
        u32x4 pa[4][2], pb[2][2], pc[2][2];
#pragma unroll
        for (int m = 0; m < 4; ++m) GATE_PLOAD(pa[m], 0, m);
#pragma unroll
        for (int m = 0; m < 2; ++m) GATE_PLOAD(pb[m], 1, m);
#define GATE_ROW(pvv, ai_, m_) do { const int row = u.pm * 256 + (ai_) * 128 + wr * 64 + (m_) * 16 + fr; const float rs = rsv[ai_][m_]; f32x4 o = (f32x4){0.f, 0.f, 0.f, 0.f}; \
            _Pragma("unroll") for (int bj = 0; bj < 2; ++bj) { const u32x4 pw = pvv[bj]; \
                const f32x4 g0 = acc[ai_][bj][m_][0] * rs + bv[bj][0], g1 = acc[ai_][bj][m_][1] * rs + bv[bj][1]; \
                o[0] += sigm(g0[0]) * bflo(pw.x) + sigm(g1[0]) * bflo(pw.z); o[1] += sigm(g0[1]) * bfhi(pw.x) + sigm(g1[1]) * bfhi(pw.z); \
                o[2] += sigm(g0[2]) * bflo(pw.y) + sigm(g1[2]) * bflo(pw.w); o[3] += sigm(g0[3]) * bfhi(pw.y) + sigm(g1[3]) * bfhi(pw.w); } \
            *(u32x2*)(MG + (size_t)row * 1024 + oc) = pk4(o); } while (0)
        GATE_ROW(pa[0], 0, 0); GATE_ROW(pa[1], 0, 1);
#pragma unroll
        for (int m = 0; m < 2; ++m) GATE_PLOAD(pc[m], 1, m + 2);
        GATE_ROW(pa[2], 0, 2); GATE_ROW(pa[3], 0, 3);
        GATE_ROW(pb[0], 1, 0); GATE_ROW(pb[1], 1, 1); GATE_ROW(pc[0], 1, 2); GATE_ROW(pc[1], 1, 3);
#undef GATE_PLOAD
#undef GATE_ROW
    }
};
struct EpiRes {
    static constexpr bool PERM = true; static constexpr bool RS = false; static constexpr int NST = 24;
    bf16_t* XB; unsigned long long* ss;
    DI void operator()(AccRef acc, const Unit& u, int wr, int wc, int fr, int fq, const LAS float* rsl) const {
        u32x4 bv[2][4][2];
#pragma unroll
        for (int ai = 0; ai < 2; ++ai)
#pragma unroll
            for (int m = 0; m < 4; ++m)
#pragma unroll
                for (int bj = 0; bj < 2; ++bj) bv[ai][m][bj] = *(const u32x4*)(XB + (size_t)(u.pm * 256 + ai * 128 + wr * 64 + m * 16 + fr) * 1024 + u.pn * 256 + bj * 128 + wc * 32 + 8 * fq);
#pragma unroll
        for (int ai = 0; ai < 2; ++ai)
#pragma unroll
            for (int m = 0; m < 4; ++m) {
                const int row = u.pm * 256 + ai * 128 + wr * 64 + m * 16 + fr; float sq = 0.f;
#pragma unroll
                for (int bj = 0; bj < 2; ++bj) {
                    const size_t off = (size_t)row * 1024 + u.pn * 256 + bj * 128 + wc * 32 + 8 * fq;
                    const u32x4 b0 = bv[ai][m][bj];
                    const f32x4 v0 = (f32x4){bflo(b0.x), bfhi(b0.x), bflo(b0.y), bfhi(b0.y)} + acc[ai][bj][m][0];
                    const f32x4 v1 = (f32x4){bflo(b0.z), bfhi(b0.z), bflo(b0.w), bfhi(b0.w)} + acc[ai][bj][m][1];
                    u32x4 w; w.x = pk2(v0[0], v0[1]); w.y = pk2(v0[2], v0[3]); w.z = pk2(v1[0], v1[1]); w.w = pk2(v1[2], v1[3]);
                    *(u32x4*)(XB + off) = w;
                    sq += ((v0[0] * v0[0] + v0[1] * v0[1]) + (v0[2] * v0[2] + v0[3] * v0[3])) + ((v1[0] * v1[0] + v1[1] * v1[1]) + (v1[2] * v1[2] + v1[3] * v1[3]));
                }
                sq += __shfl_xor(sq, 16); sq += __shfl_xor(sq, 32);
                if (fq == 0) atomicAdd(ss + row, ss_fix(sq));
            }
    }
};
struct EpiSwi {
    static constexpr bool PERM = true; static constexpr bool RS = true; static constexpr int NST = 8;
    const unsigned long long* ss; bf16_t* ACT;
    DI void operator()(AccRef acc, const Unit& u, int wr, int wc, int fr, int fq, const LAS float* rsl) const {
        float rsv[2][4];
#pragma unroll
        for (int ai = 0; ai < 2; ++ai)
#pragma unroll
            for (int m = 0; m < 4; ++m) rsv[ai][m] = rsl[ai * 128 + wr * 64 + m * 16 + fr];
        const int idx = 128 * u.pn + 32 * wc + 8 * fq;
#pragma unroll
        for (int ai = 0; ai < 2; ++ai)
#pragma unroll
            for (int m = 0; m < 4; ++m) {
                const int row = u.pm * 256 + ai * 128 + wr * 64 + m * 16 + fr;
                const float rs = rsv[ai][m];
                u32x4 w;
                { const f32x4 g = acc[ai][0][m][0] * rs, uu = acc[ai][0][m][1] * rs;
                  w.x = pk2(g[0] * sigm(g[0]) * uu[0], g[1] * sigm(g[1]) * uu[1]); w.y = pk2(g[2] * sigm(g[2]) * uu[2], g[3] * sigm(g[3]) * uu[3]); }
                { const f32x4 g = acc[ai][1][m][0] * rs, uu = acc[ai][1][m][1] * rs;
                  w.z = pk2(g[0] * sigm(g[0]) * uu[0], g[1] * sigm(g[1]) * uu[1]); w.w = pk2(g[2] * sigm(g[2]) * uu[2], g[3] * sigm(g[3]) * uu[3]); }
                *(u32x4*)(ACT + (size_t)row * FF + idx) = w;
            }
    }
};
struct LayerW { const float *g_mix, *w_in, *w_gate, *b_gate, *pool_w, *pool_scale, *sgu_g, *sgu_b, *sgu_w, *sgu_bs, *conv_w, *conv_b, *conv_g, *conv_nb, *wpa, *wpb, *wpc, *wpd, *wo, *g_ffn, *wf1, *wf2; };
DI LayerW layer_w(const Params& p, int l) {
    LayerW w;
    w.g_mix = p.in[2] + (size_t)l * 1024; w.w_in = p.in[3] + (size_t)l * 1024 * 2816; w.w_gate = p.in[4] + (size_t)l * 1024 * 4096; w.b_gate = p.in[5] + (size_t)l * 4096;
    w.pool_w = p.in[6] + (size_t)l * 4 * 64 * 64; w.pool_scale = p.in[7] + (size_t)l * 256; w.sgu_g = p.in[8] + (size_t)l * 256; w.sgu_b = p.in[9] + (size_t)l * 256;
    w.sgu_w = p.in[10] + (size_t)l * 4 * 128 * 128; w.sgu_bs = p.in[11] + (size_t)l * 4 * 128; w.conv_w = p.in[12] + (size_t)l * 31 * 256; w.conv_b = p.in[13] + (size_t)l * 256;
    w.conv_g = p.in[14] + (size_t)l * 256; w.conv_nb = p.in[15] + (size_t)l * 256; w.wpa = p.in[16] + (size_t)l * 256 * 1024; w.wpb = p.in[17] + (size_t)l * 512 * 1024;
    w.wpc = p.in[18] + (size_t)l * 256 * 1024; w.wpd = p.in[19] + (size_t)l * 256 * 1024; w.wo = p.in[20] + (size_t)l * 1024 * 1024; w.g_ffn = p.in[21] + (size_t)l * 1024;
    w.wf1 = p.in[22] + (size_t)l * 1024 * 5632; w.wf2 = p.in[23] + (size_t)l * 2816 * 1024;
    return w;
}
DI int orig_in(int nl) {
    const int tile = nl >> 8;
    if (tile == 0 || (tile >= 5 && tile <= 8)) return nl;
    const int l = nl & 63, w = l >> 5, fq = (l >> 3) & 3, n = (l >> 2) & 1, e = l & 3, idx = 16 * w + 4 * fq + e;
    if (tile <= 4) return (nl & ~63) + 32 * n + idx;
    const int blk = (nl - 2304) >> 6; return 2304 + (n ? 256 : 0) + 32 * blk + idx;
}
DI int orig_gate(int nl) { const int pn = nl >> 8, l = nl & 255, bj = l >> 7, wc = (l >> 5) & 3, fq = (l >> 3) & 3, n = (l >> 2) & 1, e = l & 3; return (2 * bj + n) * 1024 + 64 * pn + 16 * wc + 4 * fq + e; }
DI int orig_ffn(int nl) { const int pn = nl >> 8, l = nl & 255, bj = l >> 7, wc = (l >> 5) & 3, fq = (l >> 3) & 3, n = (l >> 2) & 1, e = l & 3; const int idx = 128 * pn + 32 * wc + 8 * fq + 4 * bj + e; return n ? 2816 + idx : idx; }

DI void prep_weights(const Params& p, LAS float* tile, bf16_t* wts) {
    const int TIDX = l_tid(), BIDX = l_bid(), GDIM = l_gdim();
    const int tid = TIDX;
    LAS float* PWs = tile + 256 * 65; LAS float* WAs = PWs + 64 * 65;
    for (int job = BIDX; job < 2 * 1104; job += GDIM) {
        const int l = job / 1104; int j = job % 1104; int type, tn, tk;
        if (j < 176) { type = 0; tn = j / 4; tk = j % 4; }
        else if (j < 432) { j -= 176; type = 1; tn = j / 4; tk = j % 4; }
        else if (j < 512) { j -= 432; type = 2; tn = j / 5; tk = j % 5; }
        else if (j < 576) { j -= 512; type = 3; tn = j / 4; tk = j % 4; }
        else if (j < 928) { j -= 576; type = 4; tn = j / 4; tk = j % 4; }
        else { j -= 928; type = 5; tn = j / 11; tk = j % 11; }
        const LayerW w = layer_w(p, l);
        const int n0 = tn * 64, k0 = tk * 256;
        const int n = tid & 63, kb = tid >> 6, nl = n0 + n;
        const int oc = type == 0 ? orig_in(nl) : (type == 1 ? orig_gate(nl) : (type == 4 ? orig_ffn(nl) : nl));
        __syncthreads();
        if (type == 2 && k0 == 0) {
            for (int g = 0; g < 4; ++g) {
#pragma unroll
                for (int i = 0; i < 8; ++i) { const int e = tid + 512 * i, r = e >> 6, cc = e & 63;
                    PWs[r * 65 + cc] = w.pool_w[(size_t)(g * 64 + r) * 64 + cc] * w.pool_scale[g * 64 + cc];
                    WAs[r * 64 + cc] = w.wpa[(size_t)(g * 64 + r) * 1024 + n0 + cc]; }
                __syncthreads();
#pragma unroll
                for (int i = 0; i < 8; ++i) { const int c = kb + 8 * i; float sacc = 0.f;
#pragma unroll 8
                    for (int d = 0; d < 64; ++d) sacc += PWs[c * 65 + d] * WAs[d * 64 + n];
                    tile[(g * 64 + c) * 65 + n] = sacc; }
                __syncthreads();
            }
        } else {
            const float* src; size_t ld; const float* gs = nullptr;
            if (type == 0) { src = w.w_in; ld = 2816; gs = w.g_mix; }
            else if (type == 1) { src = w.w_gate; ld = 4096; gs = w.g_mix; }
            else if (type == 2) { const int kk = k0; src = kk < 768 ? w.wpb + (size_t)(kk - 256) * 1024 : (kk < 1024 ? w.wpc + (size_t)(kk - 768) * 1024 : w.wpd + (size_t)(kk - 1024) * 1024); src -= (size_t)k0 * 1024; ld = 1024; }
            else if (type == 3) { src = w.wo; ld = 1024; }
            else if (type == 4) { src = w.wf1; ld = 5632; gs = w.g_ffn; }
            else { src = w.wf2; ld = 1024; }
            float v[32];
#pragma unroll
            for (int i = 0; i < 32; ++i) v[i] = src[(size_t)(k0 + kb + 8 * i) * ld + oc];
            if (gs) {
#pragma unroll
                for (int i = 0; i < 32; ++i) v[i] *= gs[k0 + kb + 8 * i]; }
#pragma unroll
            for (int i = 0; i < 32; ++i) tile[(kb + 8 * i) * 65 + n] = v[i];
        }
        __syncthreads();
        {
            const int nn = tid >> 3, kc = (tid & 7) * 32;
            const size_t woff = type == 0 ? W_IN : (type == 1 ? W_G : (type == 2 ? W_P : (type == 3 ? W_O : (type == 4 ? W_F1 : W_F2))));
            const int ldd = type == 2 ? 1280 : (type == 5 ? 2816 : 1024);
            bf16_t* dst = wts + (size_t)l * W_LAYER + woff + (size_t)(n0 + nn) * ldd + k0 + kc;
#pragma unroll
            for (int q = 0; q < 4; ++q) { u32x4 o;
                o.x = pk2(tile[(kc + 8 * q + 0) * 65 + nn], tile[(kc + 8 * q + 1) * 65 + nn]); o.y = pk2(tile[(kc + 8 * q + 2) * 65 + nn], tile[(kc + 8 * q + 3) * 65 + nn]);
                o.z = pk2(tile[(kc + 8 * q + 4) * 65 + nn], tile[(kc + 8 * q + 5) * 65 + nn]); o.w = pk2(tile[(kc + 8 * q + 6) * 65 + nn], tile[(kc + 8 * q + 7) * 65 + nn]);
                *(u32x4*)(dst + 8 * q) = o; }
        }
    }
}
DI void phase0_misc(const Params& p, bf16_t* XB, unsigned long long* ss, float* rope, int* cnt) {
    const int TIDX = l_tid(), BIDX = l_bid(), GDIM = l_gdim(); (void)TIDX; (void)BIDX; (void)GDIM;
    const int tid = TIDX, lane = tid & 63, wid = tid >> 6;
    const size_t gsz = (size_t)GDIM * 512, gid = (size_t)BIDX * 512 + tid;
    const float* x = p.in[0];
    for (int row0 = (BIDX * 8 + wid) * 4; row0 < MTOK; row0 += GDIM * 32) {
        f32x4 v[4][4];
#pragma unroll
        for (int r = 0; r < 4; ++r)
#pragma unroll
            for (int i = 0; i < 4; ++i) v[r][i] = *(const f32x4*)(x + (size_t)(row0 + r) * 1024 + i * 256 + lane * 4);
#pragma unroll
        for (int r = 0; r < 4; ++r) { float sq = 0.f;
#pragma unroll
            for (int i = 0; i < 4; ++i) { const f32x4 q = v[r][i]; sq += (q[0] * q[0] + q[1] * q[1]) + (q[2] * q[2] + q[3] * q[3]); *(u32x2*)(XB + (size_t)(row0 + r) * 1024 + i * 256 + lane * 4) = pk4(q); }
#pragma unroll
            for (int o = 32; o >= 1; o >>= 1) sq += __shfl_xor(sq, o);
            if (lane == 0) ss[row0 + r] = ss_fix(sq); }
    }
    const int* pos = (const int*)p.in[1];
    for (size_t i = gid; i < (size_t)MTOK * 32; i += gsz) {
        const int row = (int)(i >> 5), fi = (int)(i & 31);
        const float inv = 1.0f / powf(10000.0f, (float)fi * (1.0f / 32.0f));
        const float ang = (float)pos[row] * inv;
        const double r = (double)ang * 0.15915494309189535; const float fr = (float)(r - rint(r));
        rope[i * 2] = __builtin_amdgcn_cosf(fr); rope[i * 2 + 1] = __builtin_amdgcn_sinf(fr);
    }
    for (size_t i = gid; i < 2048; i += gsz) cnt[i] = 0;
    for (size_t i = gid; i < (size_t)4 * MTOK; i += gsz) ss[MTOK + i] = 0ull;
}

DI void kmean_phase(const bf16_t* K, float* km) {
    const int TIDX = l_tid(), BIDX = l_bid(), GDIM = l_gdim(); (void)TIDX; (void)BIDX; (void)GDIM;
    const int lane = TIDX & 63, wid = TIDX >> 6, dp = lane & 31, par = lane >> 5;
    for (int it = BIDX * 8 + wid; it < 1024; it += GDIM * 8) {
        const int b = it >> 9, h = (it >> 6) & 7, n = it & 63;
        const bf16_t* base = K + ((size_t)(b * SEQ + n * 256)) * 512 + h * 64 + 2 * dp;
        float s0 = 0.f, s1 = 0.f;
#pragma unroll 16
        for (int i = 0; i < 128; ++i) { const unsigned u = *(const unsigned*)(base + (size_t)(2 * i + par) * 512); s0 += bflo(u); s1 += bfhi(u); }
        s0 += __shfl_xor(s0, 32); s1 += __shfl_xor(s1, 32);
        if (par == 0) { f32x2 o; o.x = s0 * (1.0f / 256.0f); o.y = s1 * (1.0f / 256.0f); *(f32x2*)(km + (size_t)it * 64 + 2 * dp) = o; }
    }
}
template <int W>
DI void pool_run(const bf16_t* XA, bf16_t* Y, int run, int c8) {
    const int tok0 = run * 8, tl0 = tok0 & (SEQ - 1), ch = (W == 2 ? 0 : (W == 4 ? 64 : (W == 8 ? 128 : 192))) + c8 * 8;
    u32x4 rows[W + 7];
#pragma unroll
    for (int r = 0; r < W + 7; ++r) { rows[r] = (u32x4){0u, 0u, 0u, 0u}; if (tl0 - (W - 1) + r >= 0) rows[r] = *(const u32x4*)(XA + (size_t)(tok0 - (W - 1) + r) * 256 + ch); }
    float s[8];
#pragma unroll
    for (int i = 0; i < 8; ++i) s[i] = 0.f;
#define POOL_ADD(v, sgn) do { s[0] += sgn bflo((v).x); s[1] += sgn bfhi((v).x); s[2] += sgn bflo((v).y); s[3] += sgn bfhi((v).y); s[4] += sgn bflo((v).z); s[5] += sgn bfhi((v).z); s[6] += sgn bflo((v).w); s[7] += sgn bfhi((v).w); } while (0)
#pragma unroll
    for (int r = 0; r < W - 1; ++r) POOL_ADD(rows[r], +);
#pragma unroll
    for (int o = 0; o < 8; ++o) {
        POOL_ADD(rows[W - 1 + o], +);
        const u32x4 c = rows[W - 1 + o]; const int tl = tl0 + o; const float inv = 1.0f / (float)(tl + 1 < W ? tl + 1 : W);
        u32x4 ov; ov.x = pk2(s[0] * inv - bflo(c.x), s[1] * inv - bfhi(c.x)); ov.y = pk2(s[2] * inv - bflo(c.y), s[3] * inv - bfhi(c.y)); ov.z = pk2(s[4] * inv - bflo(c.z), s[5] * inv - bfhi(c.z)); ov.w = pk2(s[6] * inv - bflo(c.w), s[7] * inv - bfhi(c.w));
        *(u32x4*)(Y + (size_t)(tok0 + o) * 1280 + ch) = ov;
        POOL_ADD(rows[o], -);
    }
#undef POOL_ADD
}
DI void pool_phase(const bf16_t* XA, bf16_t* Y) {
    const int TIDX = l_tid(), BIDX = l_bid(), GDIM = l_gdim();
    const int gsz = GDIM * 512, gid = BIDX * 512 + TIDX;
    for (int idx = gid; idx < 131072; idx += gsz) {
        const int g = idx >> 15, run = (idx & 32767) >> 3, c8 = idx & 7;
        if (g == 0) pool_run<2>(XA, Y, run, c8); else if (g == 1) pool_run<4>(XA, Y, run, c8); else if (g == 2) pool_run<8>(XA, Y, run, c8); else pool_run<16>(XA, Y, run, c8);
    }
}
DI void conv_phase(LAS unsigned char* lds, const bf16_t* H, const LayerW& w, bf16_t* Y) {
    const int TIDX = l_tid(), BIDX = l_bid(), GDIM = l_gdim(); (void)TIDX; (void)BIDX; (void)GDIM;
    LAS bf16_t* HS = (LAS bf16_t*)lds;
    LAS float* CS = (LAS float*)(lds + 48128);
    const int tid = TIDX, lane = tid & 63, wid = tid >> 6;
    for (int tile = BIDX; tile < MTOK / 64; tile += GDIM) {
        const int t0 = tile * 64, tl0 = t0 & (SEQ - 1);
        __syncthreads();
        for (int q = tid; q < 94 * 32; q += 512) { const int r = q >> 5, cc = (q & 31) * 8; u32x4 v = (u32x4){0u, 0u, 0u, 0u};
            if (tl0 - 30 + r >= 0) v = *(const u32x4*)(H + (size_t)(t0 - 30 + r) * 256 + cc);
            *(LAS u32x4*)(HS + r * 256 + cc) = v; }
        __syncthreads();
        {
            const int c = tid & 255, hf = tid >> 8; float wj[31];
#pragma unroll
            for (int j = 0; j < 31; ++j) wj[j] = w.conv_w[j * 256 + c];
            const float cb = w.conv_b[c];
            for (int chunk = 0; chunk < 4; ++chunk) {
                const int base = 32 * hf + 8 * chunk; float o[8];
#pragma unroll
                for (int i = 0; i < 8; ++i) o[i] = cb;
#pragma unroll
                for (int i = 0; i < 38; ++i) { const float hv = bf1(HS[(base + i) * 256 + c]);
#pragma unroll
                    for (int oo = 0; oo < 8; ++oo) { const int j = i - oo; if (j >= 0 && j < 31) o[oo] += wj[j] * hv; } }
#pragma unroll
                for (int oo = 0; oo < 8; ++oo) CS[(base + oo) * 260 + c] = o[oo];
            }
        }
        __syncthreads();
        {
            const f32x4 gg = *(const f32x4*)(w.conv_g + 4 * lane), bb = *(const f32x4*)(w.conv_nb + 4 * lane);
            for (int i = 0; i < 8; ++i) { const int tk = wid * 8 + i;
                const f32x4 v = *(const LAS f32x4*)(CS + tk * 260 + 4 * lane);
                float s = (v[0] + v[1]) + (v[2] + v[3]);
#pragma unroll
                for (int o = 32; o >= 1; o >>= 1) s += __shfl_xor(s, o);
                const float mu = s * (1.0f / 256.0f); const f32x4 d = v - mu;
                float q = (d[0] * d[0] + d[1] * d[1]) + (d[2] * d[2] + d[3] * d[3]);
#pragma unroll
                for (int o = 32; o >= 1; o >>= 1) q += __shfl_xor(q, o);
                const float rstd = rsqrtf(q * (1.0f / 256.0f) + 1e-6f);
                f32x4 y = d * rstd * gg + bb;
                y[0] *= sigm(y[0]); y[1] *= sigm(y[1]); y[2] *= sigm(y[2]); y[3] *= sigm(y[3]);
                *(u32x2*)(Y + (size_t)(t0 + tk) * 1280 + 1024 + 4 * lane) = pk4(y); }
        }
    }
}
DI void sgu_phase(LAS unsigned char* lds, const bf16_t* ZC, const LayerW& w, bf16_t* Y) {
    const int TIDX = l_tid(), BIDX = l_bid(), GDIM = l_gdim();
    LAS bf16_t* VT = (LAS bf16_t*)lds;
    const int tid = TIDX, lane = tid & 63, wid = __builtin_amdgcn_readfirstlane(tid >> 6), qi = lane & 15, gq = lane >> 4;
    for (int chunk = BIDX; chunk < MTOK / 128; chunk += GDIM) {
        const int t0 = chunk * 128;
        __syncthreads();
        {
            const f32x4 gg = *(const f32x4*)(w.sgu_g + 4 * lane), bb = *(const f32x4*)(w.sgu_b + 4 * lane);
            u32x2 raw[16];
#pragma unroll
            for (int i = 0; i < 16; ++i) raw[i] = *(const u32x2*)(ZC + (size_t)(t0 + wid * 16 + i) * 512 + 256 + 4 * lane);
#pragma unroll
            for (int i = 0; i < 16; ++i) { const int tl = wid * 16 + i;
                const f32x4 v = (f32x4){bflo(raw[i].x), bfhi(raw[i].x), bflo(raw[i].y), bfhi(raw[i].y)};
                float s = (v[0] + v[1]) + (v[2] + v[3]);
#pragma unroll
                for (int o = 32; o >= 1; o >>= 1) s += __shfl_xor(s, o);
                const float mu = s * (1.0f / 256.0f); const f32x4 d = v - mu;
                float q = (d[0] * d[0] + d[1] * d[1]) + (d[2] * d[2] + d[3] * d[3]);
#pragma unroll
                for (int o = 32; o >= 1; o >>= 1) q += __shfl_xor(q, o);
                const float rstd = rsqrtf(q * (1.0f / 256.0f) + 1e-6f);
                const f32x4 y = d * rstd * gg + bb;
                const unsigned p01 = pk2(y[0], y[1]), p23 = pk2(y[2], y[3]);
                VT[(4 * lane + 0) * 136 + tl] = (bf16_t)(p01 & 0xffffu); VT[(4 * lane + 1) * 136 + tl] = (bf16_t)(p01 >> 16);
                VT[(4 * lane + 2) * 136 + tl] = (bf16_t)(p23 & 0xffffu); VT[(4 * lane + 3) * 136 + tl] = (bf16_t)(p23 >> 16); }
        }
        __syncthreads();
        {
            const int nks = (wid >> 1) + 1, t = wid * 16 + qi;
            f32x4 wa[4][4][2];
#pragma unroll
            for (int g = 0; g < 4; ++g)
#pragma unroll
                for (int ks = 0; ks < 4; ++ks) if (ks < nks) { const float* src = w.sgu_w + ((size_t)g * 128 + t) * 128 + 32 * ks + 8 * gq; wa[g][ks][0] = *(const f32x4*)src; wa[g][ks][1] = *(const f32x4*)(src + 4); }
            float bs[4];
#pragma unroll
            for (int g = 0; g < 4; ++g) bs[g] = w.sgu_bs[g * 128 + t];
#pragma unroll
            for (int g = 0; g < 4; ++g) {
                u32x2 ur[4];
#pragma unroll
                for (int nt = 0; nt < 4; ++nt) ur[nt] = *(const u32x2*)(ZC + (size_t)(t0 + t) * 512 + g * 64 + 16 * nt + 4 * gq);
                bf16x8 Wf[4];
#pragma unroll
                for (int ks = 0; ks < 4; ++ks) { u32x4 pk = (u32x4){0u, 0u, 0u, 0u};
                    if (ks < nks) { const f32x4 a = wa[g][ks][0], b = wa[g][ks][1]; const int s0 = 32 * ks + 8 * gq;
                        pk.x = pk2(s0 + 0 <= t ? a[0] : 0.f, s0 + 1 <= t ? a[1] : 0.f); pk.y = pk2(s0 + 2 <= t ? a[2] : 0.f, s0 + 3 <= t ? a[3] : 0.f);
                        pk.z = pk2(s0 + 4 <= t ? b[0] : 0.f, s0 + 5 <= t ? b[1] : 0.f); pk.w = pk2(s0 + 6 <= t ? b[2] : 0.f, s0 + 7 <= t ? b[3] : 0.f); }
                    Wf[ks] = __builtin_bit_cast(bf16x8, pk); }
#pragma unroll
                for (int nt = 0; nt < 4; ++nt) {
                    f32x4 acc = (f32x4){0.f, 0.f, 0.f, 0.f};
#pragma unroll
                    for (int ks = 0; ks < 4; ++ks) if (ks < nks) {
                        const bf16x8 vf = *(const LAS bf16x8*)(VT + (g * 64 + 16 * nt + qi) * 136 + 32 * ks + 8 * gq);
                        acc = __builtin_amdgcn_mfma_f32_16x16x32_bf16(vf, Wf[ks], acc, 0, 0, 0); }
                    const int ch = g * 64 + 16 * nt + 4 * gq;
                    f32x4 o; o[0] = bflo(ur[nt].x) * (acc[0] + bs[g]); o[1] = bfhi(ur[nt].x) * (acc[1] + bs[g]); o[2] = bflo(ur[nt].y) * (acc[2] + bs[g]); o[3] = bfhi(ur[nt].y) * (acc[3] + bs[g]);
                    *(u32x2*)(Y + (size_t)(t0 + t) * 1280 + 768 + ch) = pk4(o);
                }
            }
        }
    }
}
typedef float f32x16 __attribute__((ext_vector_type(16)));
#define TOP3_INS(s_, n_) do { const float ss_ = (s_); const int nn_ = (n_); \
        if (ss_ > v0 || (ss_ == v0 && nn_ < i0)) { v2 = v1; i2 = i1; v1 = v0; i1 = i0; v0 = ss_; i0 = nn_; } \
        else if (ss_ > v1 || (ss_ == v1 && nn_ < i1)) { v2 = v1; i2 = i1; v1 = ss_; i1 = nn_; } \
        else if (ss_ > v2 || (ss_ == v2 && nn_ < i2)) { v2 = ss_; i2 = nn_; } } while (0)
DI void gate_phase(LAS unsigned char* lds, const bf16_t* Q, const float* km, int* cnt, unsigned short* lists) {
    const int TIDX = l_tid(), BIDX = l_bid(), GDIM = l_gdim();
    LAS bf16_t* KMH = (LAS bf16_t*)lds;
    LAS bf16_t* KML = (LAS bf16_t*)(lds + 9216);
    LAS int* HIST = (LAS int*)(lds + 18432); LAS int* BASE = HIST + 64;
    const int tid = TIDX, lane = tid & 63, wid = __builtin_amdgcn_readfirstlane(tid >> 6), r = lane & 31, h5 = lane >> 5;
    for (int item = BIDX; item < 512; item += GDIM) {
        const int b = item >> 8, h = (item >> 5) & 7, seg = item & 31;
        __syncthreads();
        { const float* src = km + (size_t)(b * 8 + h) * 4096 + tid * 8; const f32x4 a = *(const f32x4*)src, c = *(const f32x4*)(src + 4);
          const float f[8] = {a[0], a[1], a[2], a[3], c[0], c[1], c[2], c[3]}; unsigned hi[4], lo[4];
#pragma unroll
          for (int i = 0; i < 4; ++i) { hi[i] = pk2(f[2 * i], f[2 * i + 1]); lo[i] = pk2(f[2 * i] - bflo(hi[i]), f[2 * i + 1] - bfhi(hi[i])); }
          const int n = tid >> 3, d0 = (tid & 7) * 8;
          *(LAS u32x4*)(KMH + n * 72 + d0) = (u32x4){hi[0], hi[1], hi[2], hi[3]}; *(LAS u32x4*)(KML + n * 72 + d0) = (u32x4){lo[0], lo[1], lo[2], lo[3]};
          if (tid < 64) HIST[tid] = 0; }
        __syncthreads();
        const int t = seg * 512 + tid, blk = t >> 8;
        int ri0 = 0, ri1 = 0, ri2 = 0;
#pragma unroll
        for (int qt = 0; qt < 2; ++qt) {
            bf16x8 Qf[4];
            { const bf16_t* qp = Q + ((size_t)(b * SEQ + seg * 512 + wid * 64 + qt * 32 + r)) * 512 + h * 64 + 8 * h5;
              Qf[0] = *(const bf16x8*)qp; Qf[1] = *(const bf16x8*)(qp + 16); Qf[2] = *(const bf16x8*)(qp + 32); Qf[3] = *(const bf16x8*)(qp + 48); }
            float v0 = -3.0e38f, v1 = -3.0e38f, v2 = -3.0e38f; int i0 = 64, i1 = 64, i2 = 64;
#pragma unroll
            for (int nt = 0; nt < 2; ++nt) {
                f32x16 c;
#pragma unroll
                for (int i = 0; i < 16; ++i) c[i] = 0.f;
#pragma unroll
                for (int ks = 0; ks < 4; ++ks) {
                    const bf16x8 kh = *(const LAS bf16x8*)(KMH + (32 * nt + r) * 72 + 16 * ks + 8 * h5), kl = *(const LAS bf16x8*)(KML + (32 * nt + r) * 72 + 16 * ks + 8 * h5);
                    c = __builtin_amdgcn_mfma_f32_32x32x16_bf16(kh, Qf[ks], c, 0, 0, 0); c = __builtin_amdgcn_mfma_f32_32x32x16_bf16(kl, Qf[ks], c, 0, 0, 0); }
                if (32 * nt < blk) {
#pragma unroll
                    for (int i = 0; i < 16; ++i) { const int n = 32 * nt + (i & 3) + 8 * (i >> 2) + 4 * h5; if (n < blk) TOP3_INS(c[i], n); } }
            }
            { const float p0 = __shfl_xor(v0, 32), p1 = __shfl_xor(v1, 32), p2 = __shfl_xor(v2, 32); const int j0 = __shfl_xor(i0, 32), j1 = __shfl_xor(i1, 32), j2 = __shfl_xor(i2, 32);
              if (j0 < 64) TOP3_INS(p0, j0); if (j1 < 64) TOP3_INS(p1, j1); if (j2 < 64) TOP3_INS(p2, j2); }
            if (h5 == qt) { ri0 = i0; ri1 = i1; ri2 = i2; }
        }
        const int i0 = ri0, i1 = ri1, i2 = ri2;
        const int nv = blk < 3 ? blk : 3; const int lb = (b * 8 + h) * 64;
        int r0 = 0, r1 = 0, r2 = 0;
        if (nv > 0) r0 = __hip_atomic_fetch_add(HIST + i0, 1, __ATOMIC_RELAXED, __HIP_MEMORY_SCOPE_WORKGROUP);
        if (nv > 1) r1 = __hip_atomic_fetch_add(HIST + i1, 1, __ATOMIC_RELAXED, __HIP_MEMORY_SCOPE_WORKGROUP);
        if (nv > 2) r2 = __hip_atomic_fetch_add(HIST + i2, 1, __ATOMIC_RELAXED, __HIP_MEMORY_SCOPE_WORKGROUP);
        __syncthreads();
        if (tid < 64) { const int hc = HIST[tid]; BASE[tid] = hc > 0 ? atomicAdd(cnt + lb + tid, hc) : 0; }
        __syncthreads();
        if (nv > 0) lists[(size_t)(lb + i0) * SEQ + BASE[i0] + r0] = (unsigned short)((t << 2) | 0);
        if (nv > 1) lists[(size_t)(lb + i1) * SEQ + BASE[i1] + r1] = (unsigned short)((t << 2) | 1);
        if (nv > 2) lists[(size_t)(lb + i2) * SEQ + BASE[i2] + r2] = (unsigned short)((t << 2) | 2);
    }
}
DI void att_core(LAS bf16_t* KS, LAS bf16_t* VT, const bf16x8 (&Qf)[4], bool causal, int wid, int r, int h5, float& mx_out, float& ls_out, f32x16 (&oa)[2]) {
    const float C2 = 0.125f * 1.4426950408889634f;
    f32x16 sa[8];
#pragma unroll
    for (int T = 0; T < 8; ++T) {
        f32x16 a;
#pragma unroll
        for (int i = 0; i < 16; ++i) a[i] = 0.f;
#pragma unroll
        for (int ks = 0; ks < 4; ++ks) { const bf16x8 kf = *(const LAS bf16x8*)(KS + (32 * T + r) * 72 + 16 * ks + 8 * h5); a = __builtin_amdgcn_mfma_f32_32x32x16_bf16(kf, Qf[ks], a, 0, 0, 0); }
        sa[T] = a;
    }
    if (causal) {
        const int lim = 32 * wid + r - 4 * h5;
#pragma unroll
        for (int T = 0; T < 8; ++T)
#pragma unroll
            for (int i = 0; i < 16; ++i) if (32 * T + (i & 3) + 8 * (i >> 2) > lim) sa[T][i] = -1.0e30f;
    }
    float mx = -1.0e30f;
#pragma unroll
    for (int T = 0; T < 8; ++T)
#pragma unroll
        for (int i = 0; i < 16; ++i) mx = fmaxf(mx, sa[T][i]);
    mx = fmaxf(mx, __shfl_xor(mx, 32));
    const f32x2 nm = (f32x2){-mx * C2, -mx * C2}, c2 = (f32x2){C2, C2};
    f32x2 lsv = (f32x2){0.f, 0.f};
#pragma unroll
    for (int T = 0; T < 8; ++T)
#pragma unroll
        for (int i = 0; i < 8; ++i) { f32x2 v = (f32x2){sa[T][2 * i], sa[T][2 * i + 1]}; v = __builtin_elementwise_fma(v, c2, nm);
            v.x = __builtin_amdgcn_exp2f(v.x); v.y = __builtin_amdgcn_exp2f(v.y); lsv += v; sa[T][2 * i] = v.x; sa[T][2 * i + 1] = v.y; }
    float ls = lsv.x + lsv.y;
    ls += __shfl_xor(ls, 32);
#pragma unroll
    for (int dt = 0; dt < 2; ++dt)
#pragma unroll
        for (int i = 0; i < 16; ++i) oa[dt][i] = 0.f;
#pragma unroll
    for (int T = 0; T < 8; ++T) {
#pragma unroll
        for (int s = 0; s < 2; ++s) {
            u32x4 pw; pw.x = pk2(sa[T][8 * s + 0], sa[T][8 * s + 1]); pw.y = pk2(sa[T][8 * s + 2], sa[T][8 * s + 3]); pw.z = pk2(sa[T][8 * s + 4], sa[T][8 * s + 5]); pw.w = pk2(sa[T][8 * s + 6], sa[T][8 * s + 7]);
            const bf16x8 pf = __builtin_bit_cast(bf16x8, pw);
#pragma unroll
            for (int dt = 0; dt < 2; ++dt) {
                const s16x4 va = *(const LAS s16x4*)(VT + (32 * dt + r) * 260 + 32 * T + 16 * s + 4 * h5), vb = *(const LAS s16x4*)(VT + (32 * dt + r) * 260 + 32 * T + 16 * s + 8 + 4 * h5);
                const bf16x8 vf = __builtin_shufflevector(va, vb, 0, 1, 2, 3, 4, 5, 6, 7);
                oa[dt] = __builtin_amdgcn_mfma_f32_32x32x16_bf16(vf, pf, oa[dt], 0, 0, 0);
            }
        }
    }
    mx_out = mx; ls_out = ls;
}
DI void attn_phase(LAS unsigned char* lds, const bf16_t* Q, const bf16_t* K, const bf16_t* V, const unsigned short* lists, const int* cnt, bf16_t* PO, f32x2* ML) {
    const int TIDX = l_tid(), BIDX = l_bid(), GDIM = l_gdim();
    LAS int* pre = (LAS int*)lds;
    LAS int* cntS = (LAS int*)(lds + 4608);
    LAS bf16_t* KS = (LAS bf16_t*)(lds + 12288);
    LAS bf16_t* VT = (LAS bf16_t*)(lds + 12288 + 36864);
    const int tid = TIDX, lane = tid & 63, wid = __builtin_amdgcn_readfirstlane(tid >> 6), r = lane & 31, h5 = lane >> 5;
    __syncthreads();
    {
        const int c0 = cnt[2 * tid], c1 = cnt[2 * tid + 1];
        cntS[2 * tid] = c0; cntS[2 * tid + 1] = c1;
        const int a = ((c0 + 255) >> 8) + 1, b2 = ((c1 + 255) >> 8) + 1, s = a + b2; int inc = s;
#pragma unroll
        for (int o = 1; o < 64; o <<= 1) { const int v = __shfl_up(inc, o); if (lane >= o) inc += v; }
        if (lane == 63) pre[1032 + wid] = inc;
        __syncthreads();
        int woff = 0; for (int i = 0; i < wid; ++i) woff += pre[1032 + i];
        const int ex = woff + inc - s; pre[2 * tid] = ex; pre[2 * tid + 1] = ex + a; if (tid == 511) pre[1024] = ex + s;
        __syncthreads();
    }
    const int total = pre[1024], per = (total + GDIM - 1) / GDIM;
    const int vb = (GDIM & 7) == 0 ? (BIDX & 7) * (GDIM >> 3) + (BIDX >> 3) : BIDX;
    const int it0 = vb * per, it1 = (it0 + per < total) ? it0 + per : total;
    if (it0 >= it1) return;
    const float C2 = 0.125f * 1.4426950408889634f;
    int L, tile;
    { int lo = 0, hi = 1023; while (lo < hi) { const int mid = (lo + hi + 1) >> 1; if (pre[mid] <= it0) lo = mid; else hi = mid - 1; } L = lo; tile = it0 - pre[lo]; }
    int curL = -1;
#define ATT_DESC(L_, tile_, tq_, slot_, valid_, causal_) do { const int cntL_ = cntS[L_], ng_ = (cntL_ + 255) >> 8; causal_ = (tile_) >= ng_; \
        if (!(causal_)) { const int idx_ = (tile_) * 256 + wid * 32 + r; valid_ = idx_ < cntL_; const unsigned e_ = (valid_) ? (unsigned)lists[(size_t)(L_) * SEQ + idx_] : 0u; tq_ = (int)(e_ >> 2); slot_ = (int)(e_ & 3u); } \
        else { tq_ = ((L_) & 63) * 256 + wid * 32 + r; slot_ = 3; valid_ = true; } } while (0)
#define ATT_LOADQ(Qd, L_, tq_) do { const bf16_t* qp_ = Q + ((size_t)((L_) >> 9) * SEQ + (tq_)) * 512 + (((L_) >> 6) & 7) * 64 + 8 * h5; \
        Qd[0] = *(const bf16x8*)qp_; Qd[1] = *(const bf16x8*)(qp_ + 16); Qd[2] = *(const bf16x8*)(qp_ + 32); Qd[3] = *(const bf16x8*)(qp_ + 48); } while (0)
    int tq, slot; bool valid, causal;
    ATT_DESC(L, tile, tq, slot, valid, causal);
    bf16x8 Qf[4];
    ATT_LOADQ(Qf, L, tq);
    for (int it = it0; it < it1; ++it) {
        int nL = L, ntile = tile + 1; if (ntile >= pre[L + 1] - pre[L]) { nL = L + 1; ntile = 0; }
        const bool has_next = it + 1 < it1;
        int ntq = 0, nslot = 0; bool nvalid = false, ncausal = false;
        if (has_next) ATT_DESC(nL, ntile, ntq, nslot, nvalid, ncausal);
        const int b = L >> 9, h = (L >> 6) & 7, n = L & 63;
        if (L != curL) {
            __syncthreads();
            { const int key = tid >> 1, part = tid & 1; const bf16_t* src = K + ((size_t)(b * SEQ + n * 256 + key)) * 512 + h * 64 + part * 32;
#pragma unroll
              for (int i = 0; i < 4; ++i) *(LAS u32x4*)(KS + key * 72 + part * 32 + 8 * i) = *(const u32x4*)(src + 8 * i); }
            { const int key = tid & 255, hf = tid >> 8; const bf16_t* src = V + ((size_t)(b * SEQ + n * 256 + key)) * 512 + h * 64 + hf * 32;
#pragma unroll
              for (int i = 0; i < 4; ++i) { const u32x4 v = *(const u32x4*)(src + 8 * i); const int d0 = hf * 32 + 8 * i;
                  VT[(d0 + 0) * 260 + key] = (bf16_t)(v.x & 0xffffu); VT[(d0 + 1) * 260 + key] = (bf16_t)(v.x >> 16); VT[(d0 + 2) * 260 + key] = (bf16_t)(v.y & 0xffffu); VT[(d0 + 3) * 260 + key] = (bf16_t)(v.y >> 16);
                  VT[(d0 + 4) * 260 + key] = (bf16_t)(v.z & 0xffffu); VT[(d0 + 5) * 260 + key] = (bf16_t)(v.z >> 16); VT[(d0 + 6) * 260 + key] = (bf16_t)(v.w & 0xffffu); VT[(d0 + 7) * 260 + key] = (bf16_t)(v.w >> 16); } }
            __syncthreads();
            curL = L;
        }
        const size_t tokg = (size_t)b * SEQ + tq;
        bf16x8 nQ[4] = {Qf[0], Qf[1], Qf[2], Qf[3]};
        float mx, ls; f32x16 oa[2];
        if (has_next) ATT_LOADQ(nQ, nL, ntq);
        att_core(KS, VT, Qf, causal, wid, r, h5, mx, ls, oa);
        if (valid) {
            const float inv = 1.0f / ls; const size_t pidx = (tokg * 8 + h) * 4 + slot;
#pragma unroll
            for (int dt = 0; dt < 2; ++dt)
#pragma unroll
                for (int gq = 0; gq < 4; ++gq) { f32x4 o; o[0] = oa[dt][4 * gq] * inv; o[1] = oa[dt][4 * gq + 1] * inv; o[2] = oa[dt][4 * gq + 2] * inv; o[3] = oa[dt][4 * gq + 3] * inv;
                    *(u32x2*)(PO + pidx * 64 + 32 * dt + 8 * gq + 4 * h5) = pk4(o); }
            if (h5 == 0) { f32x2 ml; ml.x = mx * C2; ml.y = ls; ML[pidx] = ml; }
        }
        L = nL; tile = ntile; tq = ntq; slot = nslot; valid = nvalid; causal = ncausal; Qf[0] = nQ[0]; Qf[1] = nQ[1]; Qf[2] = nQ[2]; Qf[3] = nQ[3];
    }
#undef ATT_DESC
#undef ATT_LOADQ
}
DI void combine_phase(const bf16_t* PO, const f32x2* ML, bf16_t* Y) {
    const int TIDX = l_tid(), BIDX = l_bid(), GDIM = l_gdim(); (void)TIDX; (void)BIDX; (void)GDIM;
    const size_t gsz = (size_t)GDIM * 512, gid = (size_t)BIDX * 512 + TIDX;
    for (size_t idx = gid; idx < (size_t)MTOK * 64; idx += gsz) {
        const size_t th = idx >> 3; const int part = (int)(idx & 7); const int tok = (int)(th >> 3), h = (int)(th & 7);
        const int blk = (tok & (SEQ - 1)) >> 8, nv = blk < 3 ? blk : 3;
        const f32x4 m01 = *(const f32x4*)(ML + th * 4), m23 = *(const f32x4*)(ML + th * 4 + 2);
        const float m[4] = {m01[0], m01[2], m23[0], m23[2]}, l[4] = {m01[1], m01[3], m23[1], m23[3]};
        float M = m[3];
#pragma unroll
        for (int j = 0; j < 3; ++j) if (j < nv) M = fmaxf(M, m[j]);
        float acc[8], den = 0.f;
#pragma unroll
        for (int i = 0; i < 8; ++i) acc[i] = 0.f;
#pragma unroll
        for (int j = 0; j < 4; ++j) if (j == 3 || j < nv) {
            const float wgt = l[j] * __builtin_amdgcn_exp2f(m[j] - M); den += wgt;
            const u32x4 v = *(const u32x4*)(PO + (th * 4 + j) * 64 + part * 8);
            acc[0] += wgt * bflo(v.x); acc[1] += wgt * bfhi(v.x); acc[2] += wgt * bflo(v.y); acc[3] += wgt * bfhi(v.y); acc[4] += wgt * bflo(v.z); acc[5] += wgt * bfhi(v.z); acc[6] += wgt * bflo(v.w); acc[7] += wgt * bfhi(v.w);
        }
        const float inv = 1.0f / den;
        u32x4 o; o.x = pk2(acc[0] * inv, acc[1] * inv); o.y = pk2(acc[2] * inv, acc[3] * inv); o.z = pk2(acc[4] * inv, acc[5] * inv); o.w = pk2(acc[6] * inv, acc[7] * inv);
        *(u32x4*)(Y + (size_t)tok * 1280 + 256 + h * 64 + part * 8) = o;
    }
}
DI void final_phase(const bf16_t* XB, float* out, const unsigned long long* ss, const float* g) {
    const int TIDX = l_tid(), BIDX = l_bid(), GDIM = l_gdim();
    const size_t gsz = (size_t)GDIM * 512, gid = (size_t)BIDX * 512 + TIDX;
    for (size_t i = gid; i < (size_t)MTOK * 128; i += gsz) {
        const int row = (int)(i >> 7), c8 = (int)(i & 127) * 8;
        const float rs = row_rs(ss, row);
        const u32x4 v = *(const u32x4*)(XB + i * 8); const f32x4 g0 = *(const f32x4*)(g + c8), g1 = *(const f32x4*)(g + c8 + 4);
        f32x4 o0, o1; o0[0] = bflo(v.x) * rs * g0[0]; o0[1] = bfhi(v.x) * rs * g0[1]; o0[2] = bflo(v.y) * rs * g0[2]; o0[3] = bfhi(v.y) * rs * g0[3];
        o1[0] = bflo(v.z) * rs * g1[0]; o1[1] = bfhi(v.z) * rs * g1[1]; o1[2] = bflo(v.w) * rs * g1[2]; o1[3] = bfhi(v.w) * rs * g1[3];
        *(f32x4*)(out + i * 8) = o0; *(f32x4*)(out + i * 8 + 4) = o1;
    }
}

#ifndef PROBE_MASK
#define PROBE_MASK 0u
#endif
#ifndef PROBE_END
#define PROBE_END 0u
#endif
#define PH_BEGIN(k) unsigned long long _t0_##k = 0; if ((PROBE_MASK >> (k)) & 1u) _t0_##k = __builtin_amdgcn_s_memrealtime(); if ((PROBE_END >> (k)) & 1u) { pe_on = true; }
#define PH_END(k) if ((PROBE_MASK >> (k)) & 1u) { const unsigned long long _t1 = __builtin_amdgcn_s_memrealtime(), _dt = _t1 - _t0_##k; while (__builtin_amdgcn_s_memrealtime() - _t1 < _dt) __builtin_amdgcn_s_sleep(8); }
typedef const __attribute__((address_space(4))) Params* KParams;
DI Params kparams() { KParams kp = (KParams)__builtin_amdgcn_kernarg_segment_ptr(); asm volatile("" : "+s"(kp)); Params p;
#pragma unroll
    for (int i = 0; i < 25; ++i) p.in[i] = kp->in[i];
    p.out = kp->out; p.ws = kp->ws; return p; }
#define WSP(T, off) ((T*)(p.ws + (off)))
__global__ void __launch_bounds__(512, 2) fwd_mega(Params p_unused) {
    extern __shared__ __attribute__((aligned(16))) unsigned char lds_raw[];
    LAS unsigned char* lds = (LAS unsigned char*)lds_raw;
    cg::grid_group grid = cg::this_grid();
    bool pe_on = false; unsigned long long pe_t = 0, pe_sum = 0; (void)pe_on; (void)pe_t; (void)pe_sum;
#ifdef PROBE_TOTAL
    const unsigned long long t_start = __builtin_amdgcn_s_memrealtime();
#endif
    volatile LAS unsigned* bst = (volatile LAS unsigned*)(lds + 131072);
    { const Params p = kparams(); unsigned* bar = WSP(unsigned, WS_MISC + MISC_BAR);
      (void)bar;
      if (threadIdx.x == 0) { bst[0] = 0u; bst[1] = 0u; }
      __syncthreads(); xcd_barrier_post(bar); }
#ifdef PROBE_BAR
    int bk = 0;
#define GSYNC() do { const Params p_ = kparams(); unsigned long long* arr_ = (unsigned long long*)(p_.ws + WS_MISC + MISC_BAR + 16384) + bk; ++bk; \
        if (threadIdx.x == 0) atomicMax(arr_, (unsigned long long)__builtin_amdgcn_s_memrealtime()); \
        xcd_barrier((unsigned*)(p_.ws + WS_MISC + MISC_BAR), bst); \
        const unsigned long long tl_ = __builtin_amdgcn_s_memrealtime(), ta_ = __hip_atomic_load(arr_, __ATOMIC_RELAXED, __HIP_MEMORY_SCOPE_AGENT); \
        const unsigned long long ov_ = (tl_ > ta_ ? tl_ - ta_ : 0ull) * PROBE_BAR; while (__builtin_amdgcn_s_memrealtime() - tl_ < ov_) __builtin_amdgcn_s_sleep(8); } while (0)
#else
#define GSYNC() do { const Params p_ = kparams(); xcd_barrier((unsigned*)(p_.ws + WS_MISC + MISC_BAR), bst); if (PROBE_END) { const unsigned long long tn_ = __builtin_amdgcn_s_memrealtime(); if (pe_on) pe_sum += tn_ - pe_t; pe_t = tn_; pe_on = false; } } while (0)
#endif
        { PH_BEGIN(0)
    { const Params p = kparams(); prep_weights(p, (LAS float*)lds, WSP(bf16_t, WS_WTS)); }
    { const Params p = kparams(); phase0_misc(p, WSP(bf16_t, WS_XB), WSP(unsigned long long, WS_SSP), WSP(float, WS_ROPE), WSP(int, WS_MISC + MISC_CNT)); }
          PH_END(0) }
    { const Params p = kparams(); if (p.ws == nullptr) grid.sync();     }
    GSYNC();
    for (int l = 0; l < 2; ++l) {
        { PH_BEGIN(1)
        { const Params p = kparams(); pg8::Sched<0, 11, 1024, 1024, 16> S{l_gdim(), l_bid()};
          EpiIn E{p.ws, 2 * l, WSP(unsigned long long, WS_SSP) + (size_t)(2 * l) * MTOK};
          pg8::gemm_phase(lds, WSP(bf16_t, WS_XB), WSP(bf16_t, WS_WTS) + (size_t)l * W_LAYER + W_IN, S, E); }
          PH_END(1) }
        GSYNC();
        { PH_BEGIN(2)
        { const Params p = kparams(); kmean_phase(WSP(bf16_t, WS_R + R_K), WSP(float, WS_MISC + MISC_KM)); }
          PH_END(2) }
        { PH_BEGIN(3)
        { const Params p = kparams(); pool_phase(WSP(bf16_t, WS_R + R_XA), WSP(bf16_t, WS_Y)); }
          PH_END(3) }
        { PH_BEGIN(4)
        { const Params p = kparams(); const LayerW w = layer_w(p, l); conv_phase(lds, WSP(bf16_t, WS_R + R_H), w, WSP(bf16_t, WS_Y)); }
          PH_END(4) }
        { PH_BEGIN(5)
        { const Params p = kparams(); const LayerW w = layer_w(p, l); sgu_phase(lds, WSP(bf16_t, WS_R + R_ZC), w, WSP(bf16_t, WS_Y)); }
          PH_END(5) }
        GSYNC();
        { PH_BEGIN(6)
        { const Params p = kparams(); gate_phase(lds, WSP(bf16_t, WS_R + R_Q), WSP(float, WS_MISC + MISC_KM), WSP(int, WS_MISC + MISC_CNT) + l * 1024, WSP(unsigned short, WS_R + R_LISTS)); }
          PH_END(6) }
        GSYNC();
        { PH_BEGIN(7)
        { const Params p = kparams(); attn_phase(lds, WSP(bf16_t, WS_R + R_Q), WSP(bf16_t, WS_R + R_K), WSP(bf16_t, WS_R + R_V), WSP(unsigned short, WS_R + R_LISTS), WSP(int, WS_MISC + MISC_CNT) + l * 1024, WSP(bf16_t, WS_R + R_PO), WSP(f32x2, WS_R + R_ML)); }
          PH_END(7) }
        GSYNC();
        { PH_BEGIN(8)
        { const Params p = kparams(); combine_phase(WSP(bf16_t, WS_R + R_PO), WSP(f32x2, WS_R + R_ML), WSP(bf16_t, WS_Y)); }
          PH_END(8) }
        GSYNC();
        { PH_BEGIN(9)
        { const Params p = kparams(); pg8::Sched<1, 16, 1280, 1280, 4> S{l_gdim(), l_bid()}; EpiProj E{WSP(bf16_t, WS_R)};
          pg8::gemm_phase(lds, WSP(bf16_t, WS_Y), WSP(bf16_t, WS_WTS) + (size_t)l * W_LAYER + W_P, S, E); }
          PH_END(9) }
        GSYNC();
        { PH_BEGIN(10)
        { const Params p = kparams(); pg8::Sched<0, 16, 1024, 1024, 16> S{l_gdim(), l_bid()};
          EpiGate E{WSP(unsigned long long, WS_SSP) + (size_t)(2 * l) * MTOK, p.in[5] + (size_t)l * 4096, WSP(bf16_t, WS_R), WSP(bf16_t, WS_Y)};
          pg8::gemm_phase(lds, WSP(bf16_t, WS_XB), WSP(bf16_t, WS_WTS) + (size_t)l * W_LAYER + W_G, S, E); }
          PH_END(10) }
        GSYNC();
        { PH_BEGIN(11)
        { const Params p = kparams(); pg8::Sched<0, 4, 1024, 1024, 16> S{l_gdim(), l_bid()};
          EpiRes E{WSP(bf16_t, WS_XB), WSP(unsigned long long, WS_SSP) + (size_t)(2 * l + 1) * MTOK};
          pg8::gemm_phase(lds, WSP(bf16_t, WS_Y), WSP(bf16_t, WS_WTS) + (size_t)l * W_LAYER + W_O, S, E); }
          PH_END(11) }
        GSYNC();
        { PH_BEGIN(12)
        { const Params p = kparams(); pg8::Sched<0, 22, 1024, 1024, 16> S{l_gdim(), l_bid()};
          EpiSwi E{WSP(unsigned long long, WS_SSP) + (size_t)(2 * l + 1) * MTOK, WSP(bf16_t, WS_R)};
          pg8::gemm_phase(lds, WSP(bf16_t, WS_XB), WSP(bf16_t, WS_WTS) + (size_t)l * W_LAYER + W_F1, S, E); }
          PH_END(12) }
        GSYNC();
        { PH_BEGIN(13)
        { const Params p = kparams(); pg8::Sched<0, 4, 2816, 2816, 44> S{l_gdim(), l_bid()};
          EpiRes E{WSP(bf16_t, WS_XB), WSP(unsigned long long, WS_SSP) + (size_t)(2 * l + 2) * MTOK};
          pg8::gemm_phase(lds, WSP(bf16_t, WS_R), WSP(bf16_t, WS_WTS) + (size_t)l * W_LAYER + W_F2, S, E); }
          PH_END(13) }
        GSYNC();
    }
#ifdef EXTRA_SYNCS
    for (int i = 0; i < EXTRA_SYNCS; ++i) GSYNC();
#endif
    { PH_BEGIN(14)
    { const Params p = kparams(); final_phase(WSP(bf16_t, WS_XB), p.out, WSP(unsigned long long, WS_SSP) + (size_t)4 * MTOK, p.in[24]); }
      PH_END(14) }
    if (PROBE_END) { const unsigned long long t1 = __builtin_amdgcn_s_memrealtime(); while (__builtin_amdgcn_s_memrealtime() - t1 < pe_sum) __builtin_amdgcn_s_sleep(8); }
#ifdef PROBE_TOTAL
    { const unsigned long long t1 = __builtin_amdgcn_s_memrealtime(), dt = t1 - t_start; while (__builtin_amdgcn_s_memrealtime() - t1 < dt) __builtin_amdgcn_s_sleep(8); }
#endif
}

extern "C" void kernel_launch(void* const* d_in, const int* in_sizes, int n_in, void* d_out, int out_size, void* d_ws, size_t ws_size, hipStream_t stream) {
    static int grid = 0;
    if (grid == 0) {
        int dev = 0, cus = 0, per_cu = 0;
        if (n_in != 25 || out_size != MTOK * DM || ws_size < WS_END) { fprintf(stderr, "kernel_launch: unexpected shapes / workspace (n_in %d out %d ws %zu)\n", n_in, out_size, ws_size); grid = -1; return; }
        (void)hipGetDevice(&dev); (void)hipDeviceGetAttribute(&cus, hipDeviceAttributeMultiprocessorCount, dev);
        (void)hipFuncSetAttribute((const void*)fwd_mega, hipFuncAttributeMaxDynamicSharedMemorySize, LDS_BYTES);
        (void)hipOccupancyMaxActiveBlocksPerMultiprocessor(&per_cu, (const void*)fwd_mega, 512, LDS_BYTES);
        grid = cus > 0 ? cus : 256;
    }
    if (grid < 0) return;
    (void)hipMemsetAsync((char*)d_ws + WS_MISC + MISC_BAR, 0, 32768, stream);
    Params p{};
    for (int i = 0; i < 25; ++i) p.in[i] = (const float*)d_in[i];
    p.out = (float*)d_out; p.ws = (unsigned char*)d_ws;
    void* args[] = {&p};
    hipError_t e = hipLaunchCooperativeKernel((const void*)fwd_mega, dim3(grid), dim3(512), args, LDS_BYTES, stream);
    if (e != hipSuccess) fprintf(stderr, "cooperative launch failed: %s (grid %d)\n", hipGetErrorString(e), grid);
}
```

```cpp
#include <hip/hip_runtime.h>
#include <hip/hip_cooperative_groups.h>
#include <cstdio>
namespace cg = cooperative_groups;
#define LAS __attribute__((address_space(3)))
#define DI __device__ __forceinline__
typedef unsigned short bf16_t;
typedef short bf16x8 __attribute__((ext_vector_type(8)));
typedef short s16x4 __attribute__((ext_vector_type(4)));
typedef float f32x4 __attribute__((ext_vector_type(4)));
typedef float f32x2 __attribute__((ext_vector_type(2)));
typedef unsigned u32x4 __attribute__((ext_vector_type(4)));
typedef unsigned u32x2 __attribute__((ext_vector_type(2)));

constexpr int SEQ = 16384, MTOK = 32768, DM = 1024, NIN = 2816, FF = 2816;
constexpr int LDS_BYTES = 131072 + 64;
constexpr size_t MiB = 1048576;
constexpr size_t WS_XB = 0, WS_WTS = 64 * MiB, WS_ROPE = 140 * MiB, WS_MISC = 148 * MiB, WS_Y = 150 * MiB, WS_R = 230 * MiB, WS_SSP = 494 * MiB, WS_END = 496 * MiB;
constexpr size_t R_Q = 0, R_K = 32 * MiB, R_V = 64 * MiB, R_LISTS = 96 * MiB, R_ML = 128 * MiB, R_XA = 136 * MiB, R_ZC = 152 * MiB, R_H = 184 * MiB, R_PO = 136 * MiB;
constexpr size_t W_IN = 0, W_G = W_IN + (size_t)2816 * 1024, W_P = W_G + (size_t)4096 * 1024, W_O = W_P + (size_t)1024 * 1280, W_F1 = W_O + (size_t)1024 * 1024, W_F2 = W_F1 + (size_t)5632 * 1024, W_LAYER = W_F2 + (size_t)1024 * 2816;
constexpr size_t MISC_SS = 0, MISC_KM = 5 * (size_t)MTOK * 4, MISC_CNT = MISC_KM + 1024 * 64 * 4, MISC_BAR = MISC_CNT + 2048 * 4;

DI unsigned pk2(float lo, float hi) { unsigned r; asm volatile("v_cvt_pk_bf16_f32 %0, %1, %2" : "=v"(r) : "v"(lo), "v"(hi)); return r; }
DI float bflo(unsigned u) { return __uint_as_float(u << 16); }
DI float bfhi(unsigned u) { return __uint_as_float(u & 0xffff0000u); }
DI float bf1(bf16_t u) { return __uint_as_float(((unsigned)u) << 16); }
DI float sigm(float z) { return __builtin_amdgcn_rcpf(1.0f + __expf(-z)); }
DI float gelu_t(float x) { return x * sigm(1.5957691216057308f * (x + 0.044715f * x * x * x)); }
DI u32x2 pk4(f32x4 v) { u32x2 w; w.x = pk2(v[0], v[1]); w.y = pk2(v[2], v[3]); return w; }

DI int l_tid() { int t = threadIdx.x; asm volatile("" : "+v"(t)); return t; }
DI int l_bid() { int b = blockIdx.x; asm volatile("" : "+s"(b)); return b; }
DI int l_gdim() { int b = gridDim.x; asm volatile("" : "+s"(b)); return b; }
DI float row_rs(const unsigned long long* ssp, int row) { return rsqrtf((float)ssp[row] * (1.0f / (1048576.0f * 1024.0f)) + 1e-6f); }
DI unsigned long long ss_fix(float sq) { return (unsigned long long)(sq * 1048576.0f + 0.5f); }
struct Params { const float* in[25]; float* out; unsigned char* ws; };

namespace pg8 {
constexpr int BM = 256, BK = 64, HALF = 128, HTB = HALF * BK * 2, STAGE_BYTES = 8 * HTB, NXCD = 8, WGM = 8;
DI int lds_byte(int r, int c) { const int st = (r >> 4) * 2 + (c >> 5), rr = r & 15, cc = c & 31, ob = rr * 64 + cc * 2; return st * 1024 + (ob ^ (((ob >> 9) & 1) << 5)); }
DI void stage_rc(int b, int& R, int& C) { const int st = b / 1024, sb = b % 1024, swz = sb ^ (((sb >> 9) & 1) << 5); R = (st >> 1) * 16 + swz / 64; C = (st & 1) * 32 + (swz % 64) / 2; }
DI int perm32(int rho) { const int n = rho >> 4, i = rho & 15; return 8 * (i >> 2) + 4 * n + (i & 3); }
struct Unit { int pm, pn, nt, aux; size_t aoff, boff; };
template <int MODE, int NN, int LDA, int LDB, int NT0, int NM = MTOK / 256, int PM0 = 0>
struct Sched {
    static constexpr int nM = NM, nN = NN, nwg = nM * nN, lda = LDA, ldb = LDB;
    int G, c;
    DI bool next(int i, Unit& u) const {
        const int L = i * G + c; if (L >= nwg) return false;
        int wgid = L; { constexpr int q = nwg / NXCD; const int xcd = wgid % NXCD, off = wgid / NXCD; wgid = xcd * q + off; }
        constexpr int nig = WGM * nN; const int gid = wgid / nig, fm = gid * WGM;
        const int pm = PM0 + fm + ((wgid % nig) % WGM), pn = (wgid % nig) / WGM;
        u.pm = pm;
        if (MODE == 0) { u.pn = pn; u.aux = 0; u.nt = NT0; u.aoff = (size_t)pm * BM * lda * 2; u.boff = (size_t)pn * BM * ldb * 2; }
        else { const int br = pn >> 2, pi = pn & 3; const int koff = br == 0 ? 0 : (br == 1 ? 256 : (br == 2 ? 768 : 1024));
               u.pn = pi; u.aux = br; u.nt = br == 1 ? 8 : 4; u.aoff = ((size_t)pm * BM * lda + koff) * 2; u.boff = ((size_t)pi * BM * ldb + koff) * 2; }
        return true;
    }
};

template <class Epi, class SchedT>
DI void gemm_phase(LAS unsigned char* lds, const bf16_t* A, const bf16_t* Bt, const SchedT& S, const Epi& E) {
    const int tid = l_tid(), wid = __builtin_amdgcn_readfirstlane(tid >> 6), lane = tid & 63, wr = wid >> 2, wc = wid & 3, fr = lane & 15, fq = lane >> 4;
    constexpr int lda = SchedT::lda, ldb = SchedT::ldb;
    unsigned voffA[2], voffB[2];
#pragma unroll
    for (int i = 0; i < 2; ++i) { int R, C; stage_rc(tid * 16 + i * 8192, R, C); const int Rb = Epi::PERM ? ((R & ~31) + perm32(R & 31)) : R;
        voffA[i] = (unsigned)(R * lda + C) * 2u; voffB[i] = (unsigned)(Rb * ldb + C) * 2u; }
    const size_t kstep = (size_t)(BK * 2);
    const size_t hstepA = (size_t)HALF * lda * 2, hstepB = (size_t)HALF * ldb * 2;
    const unsigned ldsw = (unsigned)wid * 1024u;
    const int aoff = lds_byte(wr * 64 + fr, fq * 8), boff = lds_byte(wc * 32 + fr, fq * 8);
#define PG8_SA(b, h) (((b) * 2 + (h)) * HTB)
#define PG8_SB(b, h) ((4 + (b) * 2 + (h)) * HTB)
#define PG8_STAGE(bufoff, gbase, voff) do { _Pragma("unroll") for (int _i = 0; _i < 2; ++_i) \
        __builtin_amdgcn_global_load_lds((const unsigned*)((const char*)(gbase) + (voff)[_i]), (LAS unsigned*)(lds + (bufoff) + ldsw + _i * 8192), 16, 0, 0); } while (0)
#define PG8_LDA(dst, b, h) do { _Pragma("unroll") for (int m = 0; m < 4; ++m) _Pragma("unroll") for (int k = 0; k < 2; ++k) dst[m][k] = *(const LAS bf16x8*)(lds + PG8_SA(b, h) + aoff + m * 2048 + k * 1024); } while (0)
#define PG8_LDB(dst, b, h) do { _Pragma("unroll") for (int n = 0; n < 2; ++n) _Pragma("unroll") for (int k = 0; k < 2; ++k) dst[n][k] = *(const LAS bf16x8*)(lds + PG8_SB(b, h) + boff + n * 2048 + k * 1024); } while (0)
#define PG8_MMA(ai, bj, At, Bt_) do { __builtin_amdgcn_s_setprio(1); _Pragma("unroll") for (int m = 0; m < 4; ++m) _Pragma("unroll") for (int n = 0; n < 2; ++n) _Pragma("unroll") for (int k = 0; k < 2; ++k) \
        acc[ai][bj][m][n] = __builtin_amdgcn_mfma_f32_16x16x32_bf16(Bt_[n][k], At[m][k], acc[ai][bj][m][n], 0, 0, 0); __builtin_amdgcn_s_setprio(0); } while (0)
#define PG8_WAIT_V(n) asm volatile("s_waitcnt vmcnt(" #n ")" ::: "memory")
#define PG8_WAIT_L(n) asm volatile("s_waitcnt lgkmcnt(" #n ")" ::: "memory")
#define PG8_BAR __builtin_amdgcn_s_barrier()
#define PG8_SCHED __builtin_amdgcn_sched_barrier(0)
    Unit cur, nxt; int ui = 0;
    if (!S.next(0, cur)) return;
    f32x4 acc[2][2][4][2];
#pragma unroll
    for (int a = 0; a < 2; ++a)
#pragma unroll
        for (int b = 0; b < 2; ++b)
#pragma unroll
            for (int m = 0; m < 4; ++m)
#pragma unroll
                for (int n = 0; n < 2; ++n) acc[a][b][m][n] = (f32x4){0.f, 0.f, 0.f, 0.f};
    bf16x8 At[4][2], B0[2][2], B1[2][2];
    const char* cA = (const char*)A + cur.aoff; const char* cB = (const char*)Bt + cur.boff;
    PG8_STAGE(PG8_SB(0, 0), cB, voffB); PG8_STAGE(PG8_SA(0, 0), cA, voffA); PG8_STAGE(PG8_SB(0, 1), cB + hstepB, voffB); PG8_STAGE(PG8_SA(0, 1), cA + hstepA, voffA);
    if (wr == 1) PG8_BAR;
    PG8_WAIT_V(4); PG8_BAR;
    PG8_STAGE(PG8_SB(1, 0), cB + kstep, voffB); PG8_STAGE(PG8_SA(1, 0), cA + kstep, voffA); PG8_STAGE(PG8_SB(1, 1), cB + hstepB + kstep, voffB);
    PG8_WAIT_V(6); PG8_BAR;
    for (;;) {
        const bool has_next = S.next(ui + 1, nxt);
        const char* nA = has_next ? (const char*)A + nxt.aoff : cA; const char* nB = has_next ? (const char*)Bt + nxt.boff : cB;
        const int nt = cur.nt;
        for (int t = 0; t < nt; t += 2) {
            const bool last = (t == nt - 2);
            const char* a1 = cA + (size_t)(t + 1) * kstep;
            const char* a2 = last ? nA : cA + (size_t)(t + 2) * kstep; const char* b2 = last ? nB : cB + (size_t)(t + 2) * kstep;
            const char* a3 = a2 + kstep; const char* b3 = b2 + kstep;
            PG8_LDB(B0, 0, 0); PG8_SCHED; PG8_LDA(At, 0, 0); PG8_STAGE(PG8_SA(1, 1), a1 + hstepA, voffA);
            PG8_WAIT_L(8); PG8_BAR; PG8_WAIT_L(0); PG8_MMA(0, 0, At, B0); PG8_BAR; PG8_SCHED;
            PG8_LDB(B1, 0, 1); PG8_STAGE(PG8_SB(0, 0), b2, voffB);
            PG8_BAR; PG8_WAIT_L(0); PG8_MMA(0, 1, At, B1); PG8_BAR;
            PG8_LDA(At, 0, 1); PG8_STAGE(PG8_SA(0, 0), a2, voffA);
            PG8_BAR; PG8_WAIT_L(0); PG8_MMA(1, 0, At, B0); PG8_BAR; PG8_SCHED;
            PG8_STAGE(PG8_SB(0, 1), b2 + hstepB, voffB);
            PG8_WAIT_V(6); PG8_BAR; PG8_MMA(1, 1, At, B1); PG8_BAR;
            PG8_LDB(B0, 1, 0); PG8_SCHED; PG8_LDA(At, 1, 0); PG8_STAGE(PG8_SA(0, 1), a2 + hstepA, voffA);
            PG8_WAIT_L(8); PG8_BAR; PG8_WAIT_L(0); PG8_MMA(0, 0, At, B0); PG8_BAR; PG8_SCHED;
            PG8_LDB(B1, 1, 1); PG8_STAGE(PG8_SB(1, 0), b3, voffB);
            PG8_BAR; PG8_WAIT_L(0); PG8_MMA(0, 1, At, B1); PG8_BAR;
            PG8_LDA(At, 1, 1); PG8_STAGE(PG8_SA(1, 0), a3, voffA);
            PG8_BAR; PG8_WAIT_L(0); PG8_MMA(1, 0, At, B0); PG8_BAR; PG8_SCHED;
            PG8_STAGE(PG8_SB(1, 1), b3 + hstepB, voffB);
            PG8_WAIT_V(6); PG8_BAR; PG8_MMA(1, 1, At, B1); PG8_BAR;
        }
        E(acc, cur, wr, wc, fr, fq);
        if (!has_next) break;
#pragma unroll
        for (int a = 0; a < 2; ++a)
#pragma unroll
            for (int b = 0; b < 2; ++b)
#pragma unroll
                for (int m = 0; m < 4; ++m)
#pragma unroll
                    for (int n = 0; n < 2; ++n) acc[a][b][m][n] = (f32x4){0.f, 0.f, 0.f, 0.f};
        cur = nxt; cA = nA; cB = nB; ++ui;
    }
    PG8_WAIT_V(0);
    if (wr == 0) PG8_BAR;
    PG8_BAR;
#undef PG8_SA
#undef PG8_SB
#undef PG8_STAGE
#undef PG8_LDA
#undef PG8_LDB
#undef PG8_MMA
#undef PG8_WAIT_V
#undef PG8_WAIT_L
#undef PG8_BAR
#undef PG8_SCHED
}
}
using pg8::Unit;
typedef const f32x4 (&AccRef)[2][2][4][2];

#define XB_TMO      128
#define XB_XCNT(j)  (256  + 64 * (j))
#define XB_XSUB(j)  (1280 + 64 * (j))
#define XB_XGEN(j)  (2304 + 64 * (j))
#define XB_TOP      3328
#define XB_TOPGEN   3392
#define XCD_BAR_WORDS 3456
#define XB_SPIN_CAP (1u << 22)
DI unsigned xb_ld(unsigned* p)              { return __hip_atomic_load(p, __ATOMIC_RELAXED, __HIP_MEMORY_SCOPE_AGENT); }
DI unsigned xb_add(unsigned* p, unsigned v) { return __hip_atomic_fetch_add(p, v, __ATOMIC_RELAXED, __HIP_MEMORY_SCOPE_AGENT); }
DI unsigned xb_xcc_id() { return (unsigned)__builtin_amdgcn_s_getreg((3 << 11) | 20) & 0xFu; }
#define XB_SPIN(cond, bar) do { unsigned _sp = 0; while (cond) { __builtin_amdgcn_s_sleep(1); \
    if ((++_sp & 255u) == 0u) { if (xb_ld(&(bar)[XB_TMO])) break; if (_sp > XB_SPIN_CAP) { atomicAdd(&(bar)[XB_TMO], 1u); break; } } } } while (0)
DI void xcd_barrier_post(unsigned* bar) { if (threadIdx.x == 0) (void)xb_add(&bar[XB_XCNT(xb_xcc_id())], 1u); }
DI void xcd_barrier_complete(unsigned* bar, unsigned x, unsigned& nloc, unsigned& nx) {
    const unsigned G = gridDim.x;
    unsigned sum, cnt, mine, sp = 0u;
    for (;;) {
        sum = 0u; cnt = 0u; mine = 0u;
#pragma unroll
        for (unsigned j = 0; j < 16; ++j) { const unsigned c = xb_ld(&bar[XB_XCNT(j)]); sum += c; cnt += (c > 0u) ? 1u : 0u; mine = (j == x) ? c : mine; }
        if (sum == G) break;
        __builtin_amdgcn_s_sleep(1);
        if ((++sp & 255u) == 0u) { if (xb_ld(&bar[XB_TMO])) break; if (sp > XB_SPIN_CAP) { atomicAdd(&bar[XB_TMO], 1u); break; } }
    }
    nloc = mine > 0u ? mine : 1u; nx = cnt > 0u ? cnt : 1u;
}
DI void xcd_barrier(unsigned* bar, volatile LAS unsigned* st) {
    asm volatile("s_waitcnt vmcnt(0)" ::: "memory");
    __syncthreads();
    if (threadIdx.x == 0) {
        const unsigned x = xb_xcc_id();
        __builtin_amdgcn_s_waitcnt(0);
        unsigned nloc = st[0], nx = st[1];
        if (nloc == 0u) { xcd_barrier_complete(bar, x, nloc, nx); st[0] = nloc; st[1] = nx; }
        const unsigned old = xb_add(&bar[XB_XSUB(x)], 1u);
        const unsigned gen = old / nloc;
        if (old + 1u == (gen + 1u) * nloc) {
            __builtin_amdgcn_fence(__ATOMIC_RELEASE, "agent");
            asm volatile("s_waitcnt vmcnt(0)" ::: "memory");
            const unsigned og = xb_add(&bar[XB_TOP], 1u);
            const unsigned tg = og / nx;
            if (og + 1u == (tg + 1u) * nx) xb_add(&bar[XB_TOPGEN], 1u);
            else XB_SPIN(xb_ld(&bar[XB_TOPGEN]) == tg, bar);
            __builtin_amdgcn_fence(__ATOMIC_ACQUIRE, "agent");
            xb_add(&bar[XB_XGEN(x)], 1u);
            asm volatile("s_waitcnt vmcnt(0)" ::: "memory");
        } else {
            XB_SPIN(xb_ld(&bar[XB_XGEN(x)]) == gen, bar);
            __builtin_amdgcn_fence(__ATOMIC_ACQUIRE, "agent");
            asm volatile("s_waitcnt vmcnt(0)" ::: "memory");
        }
    }
    __syncthreads();
}
struct EpiIn {
    static constexpr bool PERM = true; static constexpr int NST = 16;
    unsigned char* ws; int ssi;
    template <int TY> DI void run(AccRef acc, const Unit& u, int wr, int wc, int fr, int fq) const {
        const int pn = u.pn;
        const unsigned long long* ss = (const unsigned long long*)(ws + WS_SSP) + (size_t)ssi * MTOK; const float* rope = (const float*)(ws + WS_ROPE);
        bf16_t* XA = (bf16_t*)(ws + WS_R + R_XA); bf16_t* Q = (bf16_t*)(ws + WS_R + R_Q); bf16_t* K = (bf16_t*)(ws + WS_R + R_K); bf16_t* V = (bf16_t*)(ws + WS_R + R_V);
        bf16_t* ZC = (bf16_t*)(ws + WS_R + R_ZC); bf16_t* H = (bf16_t*)(ws + WS_R + R_H);
        float rsv[2][4];
#pragma unroll
        for (int ai = 0; ai < 2; ++ai)
#pragma unroll
            for (int m = 0; m < 4; ++m) rsv[ai][m] = row_rs(ss, u.pm * 256 + ai * 128 + wr * 64 + m * 16 + fr);
#pragma unroll
        for (int ai = 0; ai < 2; ++ai) {
          f32x4 rp[4][2][2];
          if (TY == 2) {
#pragma unroll
            for (int m = 0; m < 4; ++m)
#pragma unroll
                for (int w2 = 0; w2 < 1; ++w2) { const float* rb = rope + ((size_t)(u.pm * 256 + ai * 128 + wr * 64 + m * 16 + fr) * 32 + 16 * (wc & 1) + 4 * fq) * 2;
                    rp[m][0][0] = *(const f32x4*)rb; rp[m][0][1] = *(const f32x4*)(rb + 4); rp[m][1][0] = rp[m][0][0]; rp[m][1][1] = rp[m][0][1]; }
          }
#pragma unroll
            for (int m = 0; m < 4; ++m) {
                const int row = u.pm * 256 + ai * 128 + wr * 64 + m * 16 + fr;
                const float rs = rsv[ai][m];
#pragma unroll
                for (int bj = 0; bj < 2; ++bj) {
                    const f32x4 v0 = acc[ai][bj][m][0] * rs, v1 = acc[ai][bj][m][1] * rs;
                    if (TY == 0) {
                        bf16_t* dst; int ld, cb;
                        if (pn == 0) { dst = XA; ld = 256; cb = 0; } else { dst = V; ld = 512; cb = (pn - 5) * 256; }
                        u32x4 w; w.x = pk2(v0[0], v0[1]); w.y = pk2(v0[2], v0[3]); w.z = pk2(v1[0], v1[1]); w.w = pk2(v1[2], v1[3]);
                        *(u32x4*)(dst + (size_t)row * ld + cb + bj * 128 + wc * 32 + 8 * fq) = w;
                    } else if (TY == 1) {
                        u32x4 w; w.x = pk2(gelu_t(v0[0]), gelu_t(v0[1])); w.y = pk2(gelu_t(v0[2]), gelu_t(v0[3])); w.z = pk2(gelu_t(v1[0]), gelu_t(v1[1])); w.w = pk2(gelu_t(v1[2]), gelu_t(v1[3]));
                        *(u32x4*)(ZC + (size_t)row * 512 + (pn - 7) * 256 + bj * 128 + wc * 32 + 8 * fq) = w;
                    } else if (TY == 2) {
                        bf16_t* dst = pn >= 3 ? K : Q; const int hb = ((pn - 1) & 1) * 4 + bj * 2 + (wc >> 1); const int idx = 16 * (wc & 1) + 4 * fq;
                        const f32x4 r0 = rp[m][bj][0], r1 = rp[m][bj][1];
                        f32x4 o1, o2;
                        o1[0] = v0[0] * r0[0] - v1[0] * r0[1]; o2[0] = v1[0] * r0[0] + v0[0] * r0[1];
                        o1[1] = v0[1] * r0[2] - v1[1] * r0[3]; o2[1] = v1[1] * r0[2] + v0[1] * r0[3];
                        o1[2] = v0[2] * r1[0] - v1[2] * r1[1]; o2[2] = v1[2] * r1[0] + v0[2] * r1[1];
                        o1[3] = v0[3] * r1[2] - v1[3] * r1[3]; o2[3] = v1[3] * r1[2] + v0[3] * r1[3];
                        bf16_t* p = dst + (size_t)row * 512 + hb * 64 + idx;
                        *(u32x2*)p = pk4(o1); *(u32x2*)(p + 32) = pk4(o2);
                    } else {
                        const int blk = (pn - 9) * 4 + bj * 2 + (wc >> 1); const int idx = 32 * blk + 16 * (wc & 1) + 4 * fq;
                        f32x4 o; o[0] = v0[0] * sigm(v1[0]); o[1] = v0[1] * sigm(v1[1]); o[2] = v0[2] * sigm(v1[2]); o[3] = v0[3] * sigm(v1[3]);
                        *(u32x2*)(H + (size_t)row * 256 + idx) = pk4(o);
                    }
                }
            }
        }
    }
    DI void operator()(AccRef acc, const Unit& u, int wr, int wc, int fr, int fq) const {
        const int pn = u.pn;
        if (pn == 0 || pn == 5 || pn == 6) run<0>(acc, u, wr, wc, fr, fq);
        else if (pn == 7 || pn == 8) run<1>(acc, u, wr, wc, fr, fq);
        else if (pn <= 4) run<2>(acc, u, wr, wc, fr, fq);
        else run<3>(acc, u, wr, wc, fr, fq);
    }
};
struct EpiProj {
    static constexpr bool PERM = true; static constexpr int NST = 16;
    bf16_t* P;
    DI void operator()(AccRef acc, const Unit& u, int wr, int wc, int fr, int fq) const {
        const int br = u.aux;
#pragma unroll
        for (int ai = 0; ai < 2; ++ai)
#pragma unroll
            for (int m = 0; m < 4; ++m) {
                const int row = u.pm * 256 + ai * 128 + wr * 64 + m * 16 + fr;
#pragma unroll
                for (int bj = 0; bj < 2; ++bj) {
                    const f32x4 v0 = acc[ai][bj][m][0], v1 = acc[ai][bj][m][1];
                    u32x4 w; w.x = pk2(v0[0], v0[1]); w.y = pk2(v0[2], v0[3]); w.z = pk2(v1[0], v1[1]); w.w = pk2(v1[2], v1[3]);
                    *(u32x4*)(P + (size_t)row * 4096 + br * 1024 + u.pn * 256 + wc * 64 + bj * 32 + 8 * fq) = w;
                }
            }
    }
};
struct EpiGate {
    static constexpr bool PERM = true; static constexpr int NST = 8;
    const unsigned long long* ss; const float* bg; const bf16_t* P; bf16_t* MG;
    DI void operator()(AccRef acc, const Unit& u, int wr, int wc, int fr, int fq) const {
        const int oc = u.pn * 64 + 16 * wc + 4 * fq;
        const int ocp = (oc & ~255) + ((oc >> 5) & 3) * 64 + ((oc >> 7) & 1) * 32 + (oc & 31);
        float rsv[2][4];
#pragma unroll
        for (int ai = 0; ai < 2; ++ai)
#pragma unroll
            for (int m = 0; m < 4; ++m) rsv[ai][m] = row_rs(ss, u.pm * 256 + ai * 128 + wr * 64 + m * 16 + fr);
        f32x4 bv[2][2];
#pragma unroll
        for (int bj = 0; bj < 2; ++bj)
#pragma unroll
            for (int n = 0; n < 2; ++n) bv[bj][n] = *(const f32x4*)(bg + (2 * bj + n) * 1024 + oc);
#define GATE_PLOAD(dst, ai_, m_) do { _Pragma("unroll") for (int bj = 0; bj < 2; ++bj) { const bf16_t* pp = P + (size_t)(u.pm * 256 + (ai_) * 128 + wr * 64 + (m_) * 16 + fr) * 4096 + (2 * bj) * 1024 + ocp; \
            const u32x2 q0 = *(const u32x2*)pp, q1 = *(const u32x2*)(pp + 1024); dst[bj] = (u32x4){q0.x, q0.y, q1.x, q1.y}; } } while (0)
        u32x4 pa[4][2], pb[2][2], pc[2][2];
#pragma unroll
        for (int m = 0; m < 4; ++m) GATE_PLOAD(pa[m], 0, m);
#pragma unroll
        for (int m = 0; m < 2; ++m) GATE_PLOAD(pb[m], 1, m);
#define GATE_ROW(pvv, ai_, m_) do { const int row = u.pm * 256 + (ai_) * 128 + wr * 64 + (m_) * 16 + fr; const float rs = rsv[ai_][m_]; f32x4 o = (f32x4){0.f, 0.f, 0.f, 0.f}; \
            _Pragma("unroll") for (int bj = 0; bj < 2; ++bj) { const u32x4 pw = pvv[bj]; \
                const f32x4 g0 = acc[ai_][bj][m_][0] * rs + bv[bj][0], g1 = acc[ai_][bj][m_][1] * rs + bv[bj][1]; \
                o[0] += sigm(g0[0]) * bflo(pw.x) + sigm(g1[0]) * bflo(pw.z); o[1] += sigm(g0[1]) * bfhi(pw.x) + sigm(g1[1]) * bfhi(pw.z); \
                o[2] += sigm(g0[2]) * bflo(pw.y) + sigm(g1[2]) * bflo(pw.w); o[3] += sigm(g0[3]) * bfhi(pw.y) + sigm(g1[3]) * bfhi(pw.w); } \
            *(u32x2*)(MG + (size_t)row * 1024 + oc) = pk4(o); } while (0)
        GATE_ROW(pa[0], 0, 0); GATE_ROW(pa[1], 0, 1);
#pragma unroll
        for (int m = 0; m < 2; ++m) GATE_PLOAD(pc[m], 1, m + 2);
        GATE_ROW(pa[2], 0, 2); GATE_ROW(pa[3], 0, 3);
        GATE_ROW(pb[0], 1, 0); GATE_ROW(pb[1], 1, 1); GATE_ROW(pc[0], 1, 2); GATE_ROW(pc[1], 1, 3);
#undef GATE_PLOAD
#undef GATE_ROW
    }
};
struct EpiRes {
    static constexpr bool PERM = true; static constexpr int NST = 24;
    bf16_t* XB; unsigned long long* ss;
    DI void operator()(AccRef acc, const Unit& u, int wr, int wc, int fr, int fq) const {
        u32x4 bv[2][4][2];
#pragma unroll
        for (int ai = 0; ai < 2; ++ai)
#pragma unroll
            for (int m = 0; m < 4; ++m)
#pragma unroll
                for (int bj = 0; bj < 2; ++bj) bv[ai][m][bj] = *(const u32x4*)(XB + (size_t)(u.pm * 256 + ai * 128 + wr * 64 + m * 16 + fr) * 1024 + u.pn * 256 + bj * 128 + wc * 32 + 8 * fq);
#pragma unroll
        for (int ai = 0; ai < 2; ++ai)
#pragma unroll
            for (int m = 0; m < 4; ++m) {
                const int row = u.pm * 256 + ai * 128 + wr * 64 + m * 16 + fr; float sq = 0.f;
#pragma unroll
                for (int bj = 0; bj < 2; ++bj) {
                    const size_t off = (size_t)row * 1024 + u.pn * 256 + bj * 128 + wc * 32 + 8 * fq;
                    const u32x4 b0 = bv[ai][m][bj];
                    const f32x4 v0 = (f32x4){bflo(b0.x), bfhi(b0.x), bflo(b0.y), bfhi(b0.y)} + acc[ai][bj][m][0];
                    const f32x4 v1 = (f32x4){bflo(b0.z), bfhi(b0.z), bflo(b0.w), bfhi(b0.w)} + acc[ai][bj][m][1];
                    u32x4 w; w.x = pk2(v0[0], v0[1]); w.y = pk2(v0[2], v0[3]); w.z = pk2(v1[0], v1[1]); w.w = pk2(v1[2], v1[3]);
                    *(u32x4*)(XB + off) = w;
                    sq += ((v0[0] * v0[0] + v0[1] * v0[1]) + (v0[2] * v0[2] + v0[3] * v0[3])) + ((v1[0] * v1[0] + v1[1] * v1[1]) + (v1[2] * v1[2] + v1[3] * v1[3]));
                }
                sq += __shfl_xor(sq, 16); sq += __shfl_xor(sq, 32);
                if (fq == 0) atomicAdd(ss + row, ss_fix(sq));
            }
    }
};
struct EpiSwi {
    static constexpr bool PERM = true; static constexpr int NST = 8;
    const unsigned long long* ss; bf16_t* ACT;
    DI void operator()(AccRef acc, const Unit& u, int wr, int wc, int fr, int fq) const {
        float rsv[2][4];
#pragma unroll
        for (int ai = 0; ai < 2; ++ai)
#pragma unroll
            for (int m = 0; m < 4; ++m) rsv[ai][m] = row_rs(ss, u.pm * 256 + ai * 128 + wr * 64 + m * 16 + fr);
        const int idx = 128 * u.pn + 32 * wc + 8 * fq;
#pragma unroll
        for (int ai = 0; ai < 2; ++ai)
#pragma unroll
            for (int m = 0; m < 4; ++m) {
                const int row = u.pm * 256 + ai * 128 + wr * 64 + m * 16 + fr;
                const float rs = rsv[ai][m];
                u32x4 w;
                { const f32x4 g = acc[ai][0][m][0] * rs, uu = acc[ai][0][m][1] * rs;
                  w.x = pk2(g[0] * sigm(g[0]) * uu[0], g[1] * sigm(g[1]) * uu[1]); w.y = pk2(g[2] * sigm(g[2]) * uu[2], g[3] * sigm(g[3]) * uu[3]); }
                { const f32x4 g = acc[ai][1][m][0] * rs, uu = acc[ai][1][m][1] * rs;
                  w.z = pk2(g[0] * sigm(g[0]) * uu[0], g[1] * sigm(g[1]) * uu[1]); w.w = pk2(g[2] * sigm(g[2]) * uu[2], g[3] * sigm(g[3]) * uu[3]); }
                *(u32x4*)(ACT + (size_t)row * FF + idx) = w;
            }
    }
};
struct LayerW { const float *g_mix, *w_in, *w_gate, *b_gate, *pool_w, *pool_scale, *sgu_g, *sgu_b, *sgu_w, *sgu_bs, *conv_w, *conv_b, *conv_g, *conv_nb, *wpa, *wpb, *wpc, *wpd, *wo, *g_ffn, *wf1, *wf2; };
DI LayerW layer_w(const Params& p, int l) {
    LayerW w;
    w.g_mix = p.in[2] + (size_t)l * 1024; w.w_in = p.in[3] + (size_t)l * 1024 * 2816; w.w_gate = p.in[4] + (size_t)l * 1024 * 4096; w.b_gate = p.in[5] + (size_t)l * 4096;
    w.pool_w = p.in[6] + (size_t)l * 4 * 64 * 64; w.pool_scale = p.in[7] + (size_t)l * 256; w.sgu_g = p.in[8] + (size_t)l * 256; w.sgu_b = p.in[9] + (size_t)l * 256;
    w.sgu_w = p.in[10] + (size_t)l * 4 * 128 * 128; w.sgu_bs = p.in[11] + (size_t)l * 4 * 128; w.conv_w = p.in[12] + (size_t)l * 31 * 256; w.conv_b = p.in[13] + (size_t)l * 256;
    w.conv_g = p.in[14] + (size_t)l * 256; w.conv_nb = p.in[15] + (size_t)l * 256; w.wpa = p.in[16] + (size_t)l * 256 * 1024; w.wpb = p.in[17] + (size_t)l * 512 * 1024;
    w.wpc = p.in[18] + (size_t)l * 256 * 1024; w.wpd = p.in[19] + (size_t)l * 256 * 1024; w.wo = p.in[20] + (size_t)l * 1024 * 1024; w.g_ffn = p.in[21] + (size_t)l * 1024;
    w.wf1 = p.in[22] + (size_t)l * 1024 * 5632; w.wf2 = p.in[23] + (size_t)l * 2816 * 1024;
    return w;
}
DI int orig_in(int nl) {
    const int tile = nl >> 8;
    if (tile == 0 || (tile >= 5 && tile <= 8)) return nl;
    const int l = nl & 63, w = l >> 5, fq = (l >> 3) & 3, n = (l >> 2) & 1, e = l & 3, idx = 16 * w + 4 * fq + e;
    if (tile <= 4) return (nl & ~63) + 32 * n + idx;
    const int blk = (nl - 2304) >> 6; return 2304 + (n ? 256 : 0) + 32 * blk + idx;
}
DI int orig_gate(int nl) { const int pn = nl >> 8, l = nl & 255, bj = l >> 7, wc = (l >> 5) & 3, fq = (l >> 3) & 3, n = (l >> 2) & 1, e = l & 3; return (2 * bj + n) * 1024 + 64 * pn + 16 * wc + 4 * fq + e; }
DI int orig_ffn(int nl) { const int pn = nl >> 8, l = nl & 255, bj = l >> 7, wc = (l >> 5) & 3, fq = (l >> 3) & 3, n = (l >> 2) & 1, e = l & 3; const int idx = 128 * pn + 32 * wc + 8 * fq + 4 * bj + e; return n ? 2816 + idx : idx; }

DI void prep_weights(const Params& p, LAS float* tile, bf16_t* wts) {
    const int TIDX = l_tid(), BIDX = l_bid(), GDIM = l_gdim();
    const int tid = TIDX;
    LAS float* PWs = tile + 256 * 65; LAS float* WAs = PWs + 64 * 65;
    for (int job = BIDX; job < 2 * 1104; job += GDIM) {
        const int l = job / 1104; int j = job % 1104; int type, tn, tk;
        if (j < 176) { type = 0; tn = j / 4; tk = j % 4; }
        else if (j < 432) { j -= 176; type = 1; tn = j / 4; tk = j % 4; }
        else if (j < 512) { j -= 432; type = 2; tn = j / 5; tk = j % 5; }
        else if (j < 576) { j -= 512; type = 3; tn = j / 4; tk = j % 4; }
        else if (j < 928) { j -= 576; type = 4; tn = j / 4; tk = j % 4; }
        else { j -= 928; type = 5; tn = j / 11; tk = j % 11; }
        const LayerW w = layer_w(p, l);
        const int n0 = tn * 64, k0 = tk * 256;
        const int n = tid & 63, kb = tid >> 6, nl = n0 + n;
        const int oc = type == 0 ? orig_in(nl) : (type == 1 ? orig_gate(nl) : (type == 4 ? orig_ffn(nl) : nl));
        __syncthreads();
        if (type == 2 && k0 == 0) {
            for (int g = 0; g < 4; ++g) {
#pragma unroll
                for (int i = 0; i < 8; ++i) { const int e = tid + 512 * i, r = e >> 6, cc = e & 63;
                    PWs[r * 65 + cc] = w.pool_w[(size_t)(g * 64 + r) * 64 + cc] * w.pool_scale[g * 64 + cc];
                    WAs[r * 64 + cc] = w.wpa[(size_t)(g * 64 + r) * 1024 + n0 + cc]; }
                __syncthreads();
#pragma unroll
                for (int i = 0; i < 8; ++i) { const int c = kb + 8 * i; float sacc = 0.f;
#pragma unroll 8
                    for (int d = 0; d < 64; ++d) sacc += PWs[c * 65 + d] * WAs[d * 64 + n];
                    tile[(g * 64 + c) * 65 + n] = sacc; }
                __syncthreads();
            }
        } else {
            const float* src; size_t ld; const float* gs = nullptr;
            if (type == 0) { src = w.w_in; ld = 2816; gs = w.g_mix; }
            else if (type == 1) { src = w.w_gate; ld = 4096; gs = w.g_mix; }
            else if (type == 2) { const int kk = k0; src = kk < 768 ? w.wpb + (size_t)(kk - 256) * 1024 : (kk < 1024 ? w.wpc + (size_t)(kk - 768) * 1024 : w.wpd + (size_t)(kk - 1024) * 1024); src -= (size_t)k0 * 1024; ld = 1024; }
            else if (type == 3) { src = w.wo; ld = 1024; }
            else if (type == 4) { src = w.wf1; ld = 5632; gs = w.g_ffn; }
            else { src = w.wf2; ld = 1024; }
            float v[32];
#pragma unroll
            for (int i = 0; i < 32; ++i) v[i] = src[(size_t)(k0 + kb + 8 * i) * ld + oc];
            if (gs) {
#pragma unroll
                for (int i = 0; i < 32; ++i) v[i] *= gs[k0 + kb + 8 * i]; }
#pragma unroll
            for (int i = 0; i < 32; ++i) tile[(kb + 8 * i) * 65 + n] = v[i];
        }
        __syncthreads();
        {
            const int nn = tid >> 3, kc = (tid & 7) * 32;
            const size_t woff = type == 0 ? W_IN : (type == 1 ? W_G : (type == 2 ? W_P : (type == 3 ? W_O : (type == 4 ? W_F1 : W_F2))));
            const int ldd = type == 2 ? 1280 : (type == 5 ? 2816 : 1024);
            bf16_t* dst = wts + (size_t)l * W_LAYER + woff + (size_t)(n0 + nn) * ldd + k0 + kc;
#pragma unroll
            for (int q = 0; q < 4; ++q) { u32x4 o;
                o.x = pk2(tile[(kc + 8 * q + 0) * 65 + nn], tile[(kc + 8 * q + 1) * 65 + nn]); o.y = pk2(tile[(kc + 8 * q + 2) * 65 + nn], tile[(kc + 8 * q + 3) * 65 + nn]);
                o.z = pk2(tile[(kc + 8 * q + 4) * 65 + nn], tile[(kc + 8 * q + 5) * 65 + nn]); o.w = pk2(tile[(kc + 8 * q + 6) * 65 + nn], tile[(kc + 8 * q + 7) * 65 + nn]);
                *(u32x4*)(dst + 8 * q) = o; }
        }
    }
}
DI void phase0_misc(const Params& p, bf16_t* XB, unsigned long long* ss, float* rope, int* cnt) {
    const int TIDX = l_tid(), BIDX = l_bid(), GDIM = l_gdim(); (void)TIDX; (void)BIDX; (void)GDIM;
    const int tid = TIDX, lane = tid & 63, wid = tid >> 6;
    const size_t gsz = (size_t)GDIM * 512, gid = (size_t)BIDX * 512 + tid;
    const float* x = p.in[0];
    for (int row0 = (BIDX * 8 + wid) * 4; row0 < MTOK; row0 += GDIM * 32) {
        f32x4 v[4][4];
#pragma unroll
        for (int r = 0; r < 4; ++r)
#pragma unroll
            for (int i = 0; i < 4; ++i) v[r][i] = *(const f32x4*)(x + (size_t)(row0 + r) * 1024 + i * 256 + lane * 4);
#pragma unroll
        for (int r = 0; r < 4; ++r) { float sq = 0.f;
#pragma unroll
            for (int i = 0; i < 4; ++i) { const f32x4 q = v[r][i]; sq += (q[0] * q[0] + q[1] * q[1]) + (q[2] * q[2] + q[3] * q[3]); *(u32x2*)(XB + (size_t)(row0 + r) * 1024 + i * 256 + lane * 4) = pk4(q); }
#pragma unroll
            for (int o = 32; o >= 1; o >>= 1) sq += __shfl_xor(sq, o);
            if (lane == 0) ss[row0 + r] = ss_fix(sq); }
    }
    const int* pos = (const int*)p.in[1];
    for (size_t i = gid; i < (size_t)MTOK * 32; i += gsz) {
        const int row = (int)(i >> 5), fi = (int)(i & 31);
        const float inv = 1.0f / powf(10000.0f, (float)fi * (1.0f / 32.0f));
        const float ang = (float)pos[row] * inv;
        const double r = (double)ang * 0.15915494309189535; const float fr = (float)(r - rint(r));
        rope[i * 2] = __builtin_amdgcn_cosf(fr); rope[i * 2 + 1] = __builtin_amdgcn_sinf(fr);
    }
    for (size_t i = gid; i < 2048; i += gsz) cnt[i] = 0;
    for (size_t i = gid; i < (size_t)4 * MTOK; i += gsz) ss[MTOK + i] = 0ull;
}

DI void kmean_phase(const bf16_t* K, float* km) {
    const int TIDX = l_tid(), BIDX = l_bid(), GDIM = l_gdim(); (void)TIDX; (void)BIDX; (void)GDIM;
    const int lane = TIDX & 63, wid = TIDX >> 6, dp = lane & 31, par = lane >> 5;
    for (int it = BIDX * 8 + wid; it < 1024; it += GDIM * 8) {
        const int b = it >> 9, h = (it >> 6) & 7, n = it & 63;
        const bf16_t* base = K + ((size_t)(b * SEQ + n * 256)) * 512 + h * 64 + 2 * dp;
        float s0 = 0.f, s1 = 0.f;
#pragma unroll 16
        for (int i = 0; i < 128; ++i) { const unsigned u = *(const unsigned*)(base + (size_t)(2 * i + par) * 512); s0 += bflo(u); s1 += bfhi(u); }
        s0 += __shfl_xor(s0, 32); s1 += __shfl_xor(s1, 32);
        if (par == 0) { f32x2 o; o.x = s0 * (1.0f / 256.0f); o.y = s1 * (1.0f / 256.0f); *(f32x2*)(km + (size_t)it * 64 + 2 * dp) = o; }
    }
}
template <int W>
DI void pool_run(const bf16_t* XA, bf16_t* Y, int run, int c8) {
    const int tok0 = run * 8, tl0 = tok0 & (SEQ - 1), ch = (W == 2 ? 0 : (W == 4 ? 64 : (W == 8 ? 128 : 192))) + c8 * 8;
    u32x4 rows[W + 7];
#pragma unroll
    for (int r = 0; r < W + 7; ++r) { rows[r] = (u32x4){0u, 0u, 0u, 0u}; if (tl0 - (W - 1) + r >= 0) rows[r] = *(const u32x4*)(XA + (size_t)(tok0 - (W - 1) + r) * 256 + ch); }
    float s[8];
#pragma unroll
    for (int i = 0; i < 8; ++i) s[i] = 0.f;
#define POOL_ADD(v, sgn) do { s[0] += sgn bflo((v).x); s[1] += sgn bfhi((v).x); s[2] += sgn bflo((v).y); s[3] += sgn bfhi((v).y); s[4] += sgn bflo((v).z); s[5] += sgn bfhi((v).z); s[6] += sgn bflo((v).w); s[7] += sgn bfhi((v).w); } while (0)
#pragma unroll
    for (int r = 0; r < W - 1; ++r) POOL_ADD(rows[r], +);
#pragma unroll
    for (int o = 0; o < 8; ++o) {
        POOL_ADD(rows[W - 1 + o], +);
        const u32x4 c = rows[W - 1 + o]; const int tl = tl0 + o; const float inv = 1.0f / (float)(tl + 1 < W ? tl + 1 : W);
        u32x4 ov; ov.x = pk2(s[0] * inv - bflo(c.x), s[1] * inv - bfhi(c.x)); ov.y = pk2(s[2] * inv - bflo(c.y), s[3] * inv - bfhi(c.y)); ov.z = pk2(s[4] * inv - bflo(c.z), s[5] * inv - bfhi(c.z)); ov.w = pk2(s[6] * inv - bflo(c.w), s[7] * inv - bfhi(c.w));
        *(u32x4*)(Y + (size_t)(tok0 + o) * 1280 + ch) = ov;
        POOL_ADD(rows[o], -);
    }
#undef POOL_ADD
}
DI void pool_phase(const bf16_t* XA, bf16_t* Y) {
    const int TIDX = l_tid(), BIDX = l_bid(), GDIM = l_gdim();
    const int gsz = GDIM * 512, gid = BIDX * 512 + TIDX;
    for (int idx = gid; idx < 131072; idx += gsz) {
        const int g = idx >> 15, run = (idx & 32767) >> 3, c8 = idx & 7;
        if (g == 0) pool_run<2>(XA, Y, run, c8); else if (g == 1) pool_run<4>(XA, Y, run, c8); else if (g == 2) pool_run<8>(XA, Y, run, c8); else pool_run<16>(XA, Y, run, c8);
    }
}
DI void conv_phase(LAS unsigned char* lds, const bf16_t* H, const LayerW& w, bf16_t* Y) {
    const int TIDX = l_tid(), BIDX = l_bid(), GDIM = l_gdim(); (void)TIDX; (void)BIDX; (void)GDIM;
    LAS bf16_t* HS = (LAS bf16_t*)lds;
    LAS float* CS = (LAS float*)(lds + 48128);
    const int tid = TIDX, lane = tid & 63, wid = tid >> 6;
    for (int tile = BIDX; tile < MTOK / 64; tile += GDIM) {
        const int t0 = tile * 64, tl0 = t0 & (SEQ - 1);
        __syncthreads();
        for (int q = tid; q < 94 * 32; q += 512) { const int r = q >> 5, cc = (q & 31) * 8; u32x4 v = (u32x4){0u, 0u, 0u, 0u};
            if (tl0 - 30 + r >= 0) v = *(const u32x4*)(H + (size_t)(t0 - 30 + r) * 256 + cc);
            *(LAS u32x4*)(HS + r * 256 + cc) = v; }
        __syncthreads();
        {
            const int c = tid & 255, hf = tid >> 8; float wj[31];
#pragma unroll
            for (int j = 0; j < 31; ++j) wj[j] = w.conv_w[j * 256 + c];
            const float cb = w.conv_b[c];
            for (int chunk = 0; chunk < 4; ++chunk) {
                const int base = 32 * hf + 8 * chunk; float o[8];
#pragma unroll
                for (int i = 0; i < 8; ++i) o[i] = cb;
#pragma unroll
                for (int i = 0; i < 38; ++i) { const float hv = bf1(HS[(base + i) * 256 + c]);
#pragma unroll
                    for (int oo = 0; oo < 8; ++oo) { const int j = i - oo; if (j >= 0 && j < 31) o[oo] += wj[j] * hv; } }
#pragma unroll
                for (int oo = 0; oo < 8; ++oo) CS[(base + oo) * 260 + c] = o[oo];
            }
        }
        __syncthreads();
        {
            const f32x4 gg = *(const f32x4*)(w.conv_g + 4 * lane), bb = *(const f32x4*)(w.conv_nb + 4 * lane);
            for (int i = 0; i < 8; ++i) { const int tk = wid * 8 + i;
                const f32x4 v = *(const LAS f32x4*)(CS + tk * 260 + 4 * lane);
                float s = (v[0] + v[1]) + (v[2] + v[3]);
#pragma unroll
                for (int o = 32; o >= 1; o >>= 1) s += __shfl_xor(s, o);
                const float mu = s * (1.0f / 256.0f); const f32x4 d = v - mu;
                float q = (d[0] * d[0] + d[1] * d[1]) + (d[2] * d[2] + d[3] * d[3]);
#pragma unroll
                for (int o = 32; o >= 1; o >>= 1) q += __shfl_xor(q, o);
                const float rstd = rsqrtf(q * (1.0f / 256.0f) + 1e-6f);
                f32x4 y = d * rstd * gg + bb;
                y[0] *= sigm(y[0]); y[1] *= sigm(y[1]); y[2] *= sigm(y[2]); y[3] *= sigm(y[3]);
                *(u32x2*)(Y + (size_t)(t0 + tk) * 1280 + 1024 + 4 * lane) = pk4(y); }
        }
    }
}
DI void sgu_phase(LAS unsigned char* lds, const bf16_t* ZC, const LayerW& w, bf16_t* Y) {
    const int TIDX = l_tid(), BIDX = l_bid(), GDIM = l_gdim();
    LAS bf16_t* VT = (LAS bf16_t*)lds;
    const int tid = TIDX, lane = tid & 63, wid = __builtin_amdgcn_readfirstlane(tid >> 6), qi = lane & 15, gq = lane >> 4;
    for (int chunk = BIDX; chunk < MTOK / 128; chunk += GDIM) {
        const int t0 = chunk * 128;
        __syncthreads();
        {
            const f32x4 gg = *(const f32x4*)(w.sgu_g + 4 * lane), bb = *(const f32x4*)(w.sgu_b + 4 * lane);
            u32x2 raw[16];
#pragma unroll
            for (int i = 0; i < 16; ++i) raw[i] = *(const u32x2*)(ZC + (size_t)(t0 + wid * 16 + i) * 512 + 256 + 4 * lane);
#pragma unroll
            for (int i = 0; i < 16; ++i) { const int tl = wid * 16 + i;
                const f32x4 v = (f32x4){bflo(raw[i].x), bfhi(raw[i].x), bflo(raw[i].y), bfhi(raw[i].y)};
                float s = (v[0] + v[1]) + (v[2] + v[3]);
#pragma unroll
                for (int o = 32; o >= 1; o >>= 1) s += __shfl_xor(s, o);
                const float mu = s * (1.0f / 256.0f); const f32x4 d = v - mu;
                float q = (d[0] * d[0] + d[1] * d[1]) + (d[2] * d[2] + d[3] * d[3]);
#pragma unroll
                for (int o = 32; o >= 1; o >>= 1) q += __shfl_xor(q, o);
                const float rstd = rsqrtf(q * (1.0f / 256.0f) + 1e-6f);
                const f32x4 y = d * rstd * gg + bb;
                const unsigned p01 = pk2(y[0], y[1]), p23 = pk2(y[2], y[3]);
                const int tc = (tl + 8 * (lane & 15)) & 127;
                VT[(4 * lane + 0) * 136 + tc] = (bf16_t)(p01 & 0xffffu); VT[(4 * lane + 1) * 136 + tc] = (bf16_t)(p01 >> 16);
                VT[(4 * lane + 2) * 136 + tc] = (bf16_t)(p23 & 0xffffu); VT[(4 * lane + 3) * 136 + tc] = (bf16_t)(p23 >> 16); }
        }
        __syncthreads();
        {
            const int nks = (wid >> 1) + 1, t = wid * 16 + qi;
            f32x4 wa[4][4][2];
#pragma unroll
            for (int g = 0; g < 4; ++g)
#pragma unroll
                for (int ks = 0; ks < 4; ++ks) if (ks < nks) { const float* src = w.sgu_w + ((size_t)g * 128 + t) * 128 + 32 * ks + 8 * gq; wa[g][ks][0] = *(const f32x4*)src; wa[g][ks][1] = *(const f32x4*)(src + 4); }
            float bs[4];
#pragma unroll
            for (int g = 0; g < 4; ++g) bs[g] = w.sgu_bs[g * 128 + t];
#pragma unroll
            for (int g = 0; g < 4; ++g) {
                u32x2 ur[4];
#pragma unroll
                for (int nt = 0; nt < 4; ++nt) ur[nt] = *(const u32x2*)(ZC + (size_t)(t0 + t) * 512 + g * 64 + 16 * nt + 4 * gq);
                bf16x8 Wf[4];
#pragma unroll
                for (int ks = 0; ks < 4; ++ks) { u32x4 pk = (u32x4){0u, 0u, 0u, 0u};
                    if (ks < nks) { const f32x4 a = wa[g][ks][0], b = wa[g][ks][1]; const int s0 = 32 * ks + 8 * gq;
                        pk.x = pk2(s0 + 0 <= t ? a[0] : 0.f, s0 + 1 <= t ? a[1] : 0.f); pk.y = pk2(s0 + 2 <= t ? a[2] : 0.f, s0 + 3 <= t ? a[3] : 0.f);
                        pk.z = pk2(s0 + 4 <= t ? b[0] : 0.f, s0 + 5 <= t ? b[1] : 0.f); pk.w = pk2(s0 + 6 <= t ? b[2] : 0.f, s0 + 7 <= t ? b[3] : 0.f); }
                    Wf[ks] = __builtin_bit_cast(bf16x8, pk); }
#pragma unroll
                for (int nt = 0; nt < 4; ++nt) {
                    f32x4 acc = (f32x4){0.f, 0.f, 0.f, 0.f};
#pragma unroll
                    for (int ks = 0; ks < 4; ++ks) if (ks < nks) {
                        const bf16x8 vf = *(const LAS bf16x8*)(VT + (g * 64 + 16 * nt + qi) * 136 + ((32 * ks + 8 * gq + 8 * ((4 * nt + (qi >> 2)) & 15)) & 127));
                        acc = __builtin_amdgcn_mfma_f32_16x16x32_bf16(vf, Wf[ks], acc, 0, 0, 0); }
                    const int ch = g * 64 + 16 * nt + 4 * gq;
                    f32x4 o; o[0] = bflo(ur[nt].x) * (acc[0] + bs[g]); o[1] = bfhi(ur[nt].x) * (acc[1] + bs[g]); o[2] = bflo(ur[nt].y) * (acc[2] + bs[g]); o[3] = bfhi(ur[nt].y) * (acc[3] + bs[g]);
                    *(u32x2*)(Y + (size_t)(t0 + t) * 1280 + 768 + ch) = pk4(o);
                }
            }
        }
    }
}
typedef float f32x16 __attribute__((ext_vector_type(16)));
#define TOP3_INS(s_, n_) do { const float ss_ = (s_); const int nn_ = (n_); \
        if (ss_ > v0 || (ss_ == v0 && nn_ < i0)) { v2 = v1; i2 = i1; v1 = v0; i1 = i0; v0 = ss_; i0 = nn_; } \
        else if (ss_ > v1 || (ss_ == v1 && nn_ < i1)) { v2 = v1; i2 = i1; v1 = ss_; i1 = nn_; } \
        else if (ss_ > v2 || (ss_ == v2 && nn_ < i2)) { v2 = ss_; i2 = nn_; } } while (0)
DI void gate_phase(LAS unsigned char* lds, const bf16_t* Q, const float* km, int* cnt, unsigned short* lists) {
    const int TIDX = l_tid(), BIDX = l_bid(), GDIM = l_gdim();
    LAS bf16_t* KMH = (LAS bf16_t*)lds;
    LAS bf16_t* KML = (LAS bf16_t*)(lds + 9216);
    LAS int* HIST = (LAS int*)(lds + 18432); LAS int* BASE = HIST + 64;
    const int tid = TIDX, lane = tid & 63, wid = __builtin_amdgcn_readfirstlane(tid >> 6), r = lane & 31, h5 = lane >> 5;
    for (int item = BIDX; item < 512; item += GDIM) {
        const int b = item >> 8, h = (item >> 5) & 7, seg = item & 31;
        __syncthreads();
        { const float* src = km + (size_t)(b * 8 + h) * 4096 + tid * 8; const f32x4 a = *(const f32x4*)src, c = *(const f32x4*)(src + 4);
          const float f[8] = {a[0], a[1], a[2], a[3], c[0], c[1], c[2], c[3]}; unsigned hi[4], lo[4];
#pragma unroll
          for (int i = 0; i < 4; ++i) { hi[i] = pk2(f[2 * i], f[2 * i + 1]); lo[i] = pk2(f[2 * i] - bflo(hi[i]), f[2 * i + 1] - bfhi(hi[i])); }
          const int n = tid >> 3, d0 = (tid & 7) * 8;
          *(LAS u32x4*)(KMH + n * 72 + d0) = (u32x4){hi[0], hi[1], hi[2], hi[3]}; *(LAS u32x4*)(KML + n * 72 + d0) = (u32x4){lo[0], lo[1], lo[2], lo[3]};
          if (tid < 64) HIST[tid] = 0; }
        __syncthreads();
        const int t = seg * 512 + tid, blk = t >> 8;
        int ri0 = 0, ri1 = 0, ri2 = 0;
#pragma unroll
        for (int qt = 0; qt < 2; ++qt) {
            bf16x8 Qf[4];
            { const bf16_t* qp = Q + ((size_t)(b * SEQ + seg * 512 + wid * 64 + qt * 32 + r)) * 512 + h * 64 + 8 * h5;
              Qf[0] = *(const bf16x8*)qp; Qf[1] = *(const bf16x8*)(qp + 16); Qf[2] = *(const bf16x8*)(qp + 32); Qf[3] = *(const bf16x8*)(qp + 48); }
            float v0 = -3.0e38f, v1 = -3.0e38f, v2 = -3.0e38f; int i0 = 64, i1 = 64, i2 = 64;
#pragma unroll
            for (int nt = 0; nt < 2; ++nt) {
                f32x16 c;
#pragma unroll
                for (int i = 0; i < 16; ++i) c[i] = 0.f;
#pragma unroll
                for (int ks = 0; ks < 4; ++ks) {
                    const bf16x8 kh = *(const LAS bf16x8*)(KMH + (32 * nt + r) * 72 + 16 * ks + 8 * h5), kl = *(const LAS bf16x8*)(KML + (32 * nt + r) * 72 + 16 * ks + 8 * h5);
                    c = __builtin_amdgcn_mfma_f32_32x32x16_bf16(kh, Qf[ks], c, 0, 0, 0); c = __builtin_amdgcn_mfma_f32_32x32x16_bf16(kl, Qf[ks], c, 0, 0, 0); }
                if (32 * nt < blk) {
#pragma unroll
                    for (int i = 0; i < 16; ++i) { const int n = 32 * nt + (i & 3) + 8 * (i >> 2) + 4 * h5; if (n < blk) TOP3_INS(c[i], n); } }
            }
            { const float p0 = __shfl_xor(v0, 32), p1 = __shfl_xor(v1, 32), p2 = __shfl_xor(v2, 32); const int j0 = __shfl_xor(i0, 32), j1 = __shfl_xor(i1, 32), j2 = __shfl_xor(i2, 32);
              if (j0 < 64) TOP3_INS(p0, j0); if (j1 < 64) TOP3_INS(p1, j1); if (j2 < 64) TOP3_INS(p2, j2); }
            if (h5 == qt) { ri0 = i0; ri1 = i1; ri2 = i2; }
        }
        const int i0 = ri0, i1 = ri1, i2 = ri2;
        const int nv = blk < 3 ? blk : 3; const int lb = (b * 8 + h) * 64;
        int r0 = 0, r1 = 0, r2 = 0;
        if (nv > 0) r0 = __hip_atomic_fetch_add(HIST + i0, 1, __ATOMIC_RELAXED, __HIP_MEMORY_SCOPE_WORKGROUP);
        if (nv > 1) r1 = __hip_atomic_fetch_add(HIST + i1, 1, __ATOMIC_RELAXED, __HIP_MEMORY_SCOPE_WORKGROUP);
        if (nv > 2) r2 = __hip_atomic_fetch_add(HIST + i2, 1, __ATOMIC_RELAXED, __HIP_MEMORY_SCOPE_WORKGROUP);
        __syncthreads();
        if (tid < 64) { const int hc = HIST[tid]; BASE[tid] = hc > 0 ? atomicAdd(cnt + lb + tid, hc) : 0; }
        __syncthreads();
        if (nv > 0) lists[(size_t)(lb + i0) * SEQ + BASE[i0] + r0] = (unsigned short)((t << 2) | 0);
        if (nv > 1) lists[(size_t)(lb + i1) * SEQ + BASE[i1] + r1] = (unsigned short)((t << 2) | 1);
        if (nv > 2) lists[(size_t)(lb + i2) * SEQ + BASE[i2] + r2] = (unsigned short)((t << 2) | 2);
    }
}
DI void att_core(LAS bf16_t* KS, LAS bf16_t* VT, const bf16x8 (&Qf)[4], bool causal, int wid, int r, int h5, float& mx_out, float& ls_out, f32x16 (&oa)[2]) {
    const float C2 = 0.125f * 1.4426950408889634f;
    f32x16 sa[8];
#pragma unroll
    for (int T = 0; T < 8; ++T) {
        f32x16 a;
#pragma unroll
        for (int i = 0; i < 16; ++i) a[i] = 0.f;
#pragma unroll
        for (int ks = 0; ks < 4; ++ks) { const bf16x8 kf = *(const LAS bf16x8*)(KS + (32 * T + r) * 72 + 16 * ks + 8 * h5); a = __builtin_amdgcn_mfma_f32_32x32x16_bf16(kf, Qf[ks], a, 0, 0, 0); }
        sa[T] = a;
    }
    if (causal) {
        const int lim = 32 * wid + r - 4 * h5;
#pragma unroll
        for (int T = 0; T < 8; ++T)
#pragma unroll
            for (int i = 0; i < 16; ++i) if (32 * T + (i & 3) + 8 * (i >> 2) > lim) sa[T][i] = -1.0e30f;
    }
    float mx = -1.0e30f;
#pragma unroll
    for (int T = 0; T < 8; ++T)
#pragma unroll
        for (int i = 0; i < 16; ++i) mx = fmaxf(mx, sa[T][i]);
    mx = fmaxf(mx, __shfl_xor(mx, 32));
    const f32x2 nm = (f32x2){-mx * C2, -mx * C2}, c2 = (f32x2){C2, C2};
    f32x2 lsv = (f32x2){0.f, 0.f};
#pragma unroll
    for (int T = 0; T < 8; ++T)
#pragma unroll
        for (int i = 0; i < 8; ++i) { f32x2 v = (f32x2){sa[T][2 * i], sa[T][2 * i + 1]}; v = __builtin_elementwise_fma(v, c2, nm);
            v.x = __builtin_amdgcn_exp2f(v.x); v.y = __builtin_amdgcn_exp2f(v.y); lsv += v; sa[T][2 * i] = v.x; sa[T][2 * i + 1] = v.y; }
    float ls = lsv.x + lsv.y;
    ls += __shfl_xor(ls, 32);
#pragma unroll
    for (int dt = 0; dt < 2; ++dt)
#pragma unroll
        for (int i = 0; i < 16; ++i) oa[dt][i] = 0.f;
#pragma unroll
    for (int T = 0; T < 8; ++T) {
#pragma unroll
        for (int s = 0; s < 2; ++s) {
            u32x4 pw; pw.x = pk2(sa[T][8 * s + 0], sa[T][8 * s + 1]); pw.y = pk2(sa[T][8 * s + 2], sa[T][8 * s + 3]); pw.z = pk2(sa[T][8 * s + 4], sa[T][8 * s + 5]); pw.w = pk2(sa[T][8 * s + 6], sa[T][8 * s + 7]);
            const bf16x8 pf = __builtin_bit_cast(bf16x8, pw);
#pragma unroll
            for (int dt = 0; dt < 2; ++dt) {
                const s16x4 va = *(const LAS s16x4*)(VT + (32 * dt + r) * 260 + 32 * T + 16 * s + 4 * h5), vb = *(const LAS s16x4*)(VT + (32 * dt + r) * 260 + 32 * T + 16 * s + 8 + 4 * h5);
                const bf16x8 vf = __builtin_shufflevector(va, vb, 0, 1, 2, 3, 4, 5, 6, 7);
                oa[dt] = __builtin_amdgcn_mfma_f32_32x32x16_bf16(vf, pf, oa[dt], 0, 0, 0);
            }
        }
    }
    mx_out = mx; ls_out = ls;
}
DI void attn_phase(LAS unsigned char* lds, const bf16_t* Q, const bf16_t* K, const bf16_t* V, const unsigned short* lists, const int* cnt, bf16_t* PO, f32x2* ML) {
    const int TIDX = l_tid(), BIDX = l_bid(), GDIM = l_gdim();
    LAS int* pre = (LAS int*)lds;
    LAS int* cntS = (LAS int*)(lds + 4608);
    LAS bf16_t* KS = (LAS bf16_t*)(lds + 12288);
    LAS bf16_t* VT = (LAS bf16_t*)(lds + 12288 + 36864);
    const int tid = TIDX, lane = tid & 63, wid = __builtin_amdgcn_readfirstlane(tid >> 6), r = lane & 31, h5 = lane >> 5;
    __syncthreads();
    {
        const int c0 = cnt[2 * tid], c1 = cnt[2 * tid + 1];
        cntS[2 * tid] = c0; cntS[2 * tid + 1] = c1;
        const int a = ((c0 + 255) >> 8) + 1, b2 = ((c1 + 255) >> 8) + 1, s = a + b2; int inc = s;
#pragma unroll
        for (int o = 1; o < 64; o <<= 1) { const int v = __shfl_up(inc, o); if (lane >= o) inc += v; }
        if (lane == 63) pre[1032 + wid] = inc;
        __syncthreads();
        int woff = 0; for (int i = 0; i < wid; ++i) woff += pre[1032 + i];
        const int ex = woff + inc - s; pre[2 * tid] = ex; pre[2 * tid + 1] = ex + a; if (tid == 511) pre[1024] = ex + s;
        __syncthreads();
    }
    const int total = pre[1024], per = (total + GDIM - 1) / GDIM;
    const int it0 = BIDX * per, it1 = (it0 + per < total) ? it0 + per : total;
    if (it0 >= it1) return;
    const float C2 = 0.125f * 1.4426950408889634f;
    int L, tile;
    { int lo = 0, hi = 1023; while (lo < hi) { const int mid = (lo + hi + 1) >> 1; if (pre[mid] <= it0) lo = mid; else hi = mid - 1; } L = lo; tile = it0 - pre[lo]; }
    int curL = -1;
#define ATT_DESC(L_, tile_, tq_, slot_, valid_, causal_) do { const int cntL_ = cntS[L_], ng_ = (cntL_ + 255) >> 8; causal_ = (tile_) >= ng_; \
        if (!(causal_)) { const int idx_ = (tile_) * 256 + wid * 32 + r; valid_ = idx_ < cntL_; const unsigned e_ = (valid_) ? (unsigned)lists[(size_t)(L_) * SEQ + idx_] : 0u; tq_ = (int)(e_ >> 2); slot_ = (int)(e_ & 3u); } \
        else { tq_ = ((L_) & 63) * 256 + wid * 32 + r; slot_ = 3; valid_ = true; } } while (0)
#define ATT_LOADQ(Qd, L_, tq_) do { const bf16_t* qp_ = Q + ((size_t)((L_) >> 9) * SEQ + (tq_)) * 512 + (((L_) >> 6) & 7) * 64 + 8 * h5; \
        Qd[0] = *(const bf16x8*)qp_; Qd[1] = *(const bf16x8*)(qp_ + 16); Qd[2] = *(const bf16x8*)(qp_ + 32); Qd[3] = *(const bf16x8*)(qp_ + 48); } while (0)
    int tq, slot; bool valid, causal;
    ATT_DESC(L, tile, tq, slot, valid, causal);
    bf16x8 Qf[4];
    ATT_LOADQ(Qf, L, tq);
    for (int it = it0; it < it1; ++it) {
        int nL = L, ntile = tile + 1; if (ntile >= pre[L + 1] - pre[L]) { nL = L + 1; ntile = 0; }
        const bool has_next = it + 1 < it1;
        int ntq = 0, nslot = 0; bool nvalid = false, ncausal = false;
        if (has_next) ATT_DESC(nL, ntile, ntq, nslot, nvalid, ncausal);
        const int b = L >> 9, h = (L >> 6) & 7, n = L & 63;
        if (L != curL) {
            __syncthreads();
            { const int key = tid >> 1, part = tid & 1; const bf16_t* src = K + ((size_t)(b * SEQ + n * 256 + key)) * 512 + h * 64 + part * 32;
#pragma unroll
              for (int i = 0; i < 4; ++i) *(LAS u32x4*)(KS + key * 72 + part * 32 + 8 * i) = *(const u32x4*)(src + 8 * i); }
            { const int key = tid & 255, hf = tid >> 8; const bf16_t* src = V + ((size_t)(b * SEQ + n * 256 + key)) * 512 + h * 64 + hf * 32;
#pragma unroll
              for (int i = 0; i < 4; ++i) { const u32x4 v = *(const u32x4*)(src + 8 * i); const int d0 = hf * 32 + 8 * i;
                  VT[(d0 + 0) * 260 + key] = (bf16_t)(v.x & 0xffffu); VT[(d0 + 1) * 260 + key] = (bf16_t)(v.x >> 16); VT[(d0 + 2) * 260 + key] = (bf16_t)(v.y & 0xffffu); VT[(d0 + 3) * 260 + key] = (bf16_t)(v.y >> 16);
                  VT[(d0 + 4) * 260 + key] = (bf16_t)(v.z & 0xffffu); VT[(d0 + 5) * 260 + key] = (bf16_t)(v.z >> 16); VT[(d0 + 6) * 260 + key] = (bf16_t)(v.w & 0xffffu); VT[(d0 + 7) * 260 + key] = (bf16_t)(v.w >> 16); } }
            __syncthreads();
            curL = L;
        }
        const size_t tokg = (size_t)b * SEQ + tq;
        bf16x8 nQ[4] = {Qf[0], Qf[1], Qf[2], Qf[3]};
        float mx, ls; f32x16 oa[2];
        if (has_next) ATT_LOADQ(nQ, nL, ntq);
        att_core(KS, VT, Qf, causal, wid, r, h5, mx, ls, oa);
        if (valid) {
            const float inv = 1.0f / ls; const size_t pidx = (tokg * 8 + h) * 4 + slot;
#pragma unroll
            for (int dt = 0; dt < 2; ++dt)
#pragma unroll
                for (int gq = 0; gq < 4; ++gq) { f32x4 o; o[0] = oa[dt][4 * gq] * inv; o[1] = oa[dt][4 * gq + 1] * inv; o[2] = oa[dt][4 * gq + 2] * inv; o[3] = oa[dt][4 * gq + 3] * inv;
                    *(u32x2*)(PO + pidx * 64 + 32 * dt + 8 * gq + 4 * h5) = pk4(o); }
            if (h5 == 0) { f32x2 ml; ml.x = mx * C2; ml.y = ls; ML[pidx] = ml; }
        }
        L = nL; tile = ntile; tq = ntq; slot = nslot; valid = nvalid; causal = ncausal; Qf[0] = nQ[0]; Qf[1] = nQ[1]; Qf[2] = nQ[2]; Qf[3] = nQ[3];
    }
#undef ATT_DESC
#undef ATT_LOADQ
}
DI void combine_phase(const bf16_t* PO, const f32x2* ML, bf16_t* Y) {
    const int TIDX = l_tid(), BIDX = l_bid(), GDIM = l_gdim(); (void)TIDX; (void)BIDX; (void)GDIM;
    const size_t gsz = (size_t)GDIM * 512, gid = (size_t)BIDX * 512 + TIDX;
    for (size_t idx = gid; idx < (size_t)MTOK * 64; idx += gsz) {
        const size_t th = idx >> 3; const int part = (int)(idx & 7); const int tok = (int)(th >> 3), h = (int)(th & 7);
        const int blk = (tok & (SEQ - 1)) >> 8, nv = blk < 3 ? blk : 3;
        const f32x4 m01 = *(const f32x4*)(ML + th * 4), m23 = *(const f32x4*)(ML + th * 4 + 2);
        const float m[4] = {m01[0], m01[2], m23[0], m23[2]}, l[4] = {m01[1], m01[3], m23[1], m23[3]};
        float M = m[3];
#pragma unroll
        for (int j = 0; j < 3; ++j) if (j < nv) M = fmaxf(M, m[j]);
        float acc[8], den = 0.f;
#pragma unroll
        for (int i = 0; i < 8; ++i) acc[i] = 0.f;
#pragma unroll
        for (int j = 0; j < 4; ++j) if (j == 3 || j < nv) {
            const float wgt = l[j] * __builtin_amdgcn_exp2f(m[j] - M); den += wgt;
            const u32x4 v = *(const u32x4*)(PO + (th * 4 + j) * 64 + part * 8);
            acc[0] += wgt * bflo(v.x); acc[1] += wgt * bfhi(v.x); acc[2] += wgt * bflo(v.y); acc[3] += wgt * bfhi(v.y); acc[4] += wgt * bflo(v.z); acc[5] += wgt * bfhi(v.z); acc[6] += wgt * bflo(v.w); acc[7] += wgt * bfhi(v.w);
        }
        const float inv = 1.0f / den;
        u32x4 o; o.x = pk2(acc[0] * inv, acc[1] * inv); o.y = pk2(acc[2] * inv, acc[3] * inv); o.z = pk2(acc[4] * inv, acc[5] * inv); o.w = pk2(acc[6] * inv, acc[7] * inv);
        *(u32x4*)(Y + (size_t)tok * 1280 + 256 + h * 64 + part * 8) = o;
    }
}
DI void final_phase(const bf16_t* XB, float* out, const unsigned long long* ss, const float* g) {
    const int TIDX = l_tid(), BIDX = l_bid(), GDIM = l_gdim();
    const size_t gsz = (size_t)GDIM * 512, gid = (size_t)BIDX * 512 + TIDX;
    for (size_t i = gid; i < (size_t)MTOK * 128; i += gsz) {
        const int row = (int)(i >> 7), c8 = (int)(i & 127) * 8;
        const float rs = row_rs(ss, row);
        const u32x4 v = *(const u32x4*)(XB + i * 8); const f32x4 g0 = *(const f32x4*)(g + c8), g1 = *(const f32x4*)(g + c8 + 4);
        f32x4 o0, o1; o0[0] = bflo(v.x) * rs * g0[0]; o0[1] = bfhi(v.x) * rs * g0[1]; o0[2] = bflo(v.y) * rs * g0[2]; o0[3] = bfhi(v.y) * rs * g0[3];
        o1[0] = bflo(v.z) * rs * g1[0]; o1[1] = bfhi(v.z) * rs * g1[1]; o1[2] = bflo(v.w) * rs * g1[2]; o1[3] = bfhi(v.w) * rs * g1[3];
        *(f32x4*)(out + i * 8) = o0; *(f32x4*)(out + i * 8 + 4) = o1;
    }
}

#ifndef PROBE_MASK
#define PROBE_MASK 0u
#endif
#ifndef PROBE_END
#define PROBE_END 0u
#endif
#define PH_BEGIN(k) unsigned long long _t0_##k = 0; if ((PROBE_MASK >> (k)) & 1u) _t0_##k = __builtin_amdgcn_s_memrealtime(); if ((PROBE_END >> (k)) & 1u) { pe_on = true; }
#define PH_END(k) if ((PROBE_MASK >> (k)) & 1u) { const unsigned long long _t1 = __builtin_amdgcn_s_memrealtime(), _dt = _t1 - _t0_##k; while (__builtin_amdgcn_s_memrealtime() - _t1 < _dt) __builtin_amdgcn_s_sleep(8); }
typedef const __attribute__((address_space(4))) Params* KParams;
DI Params kparams() { KParams kp = (KParams)__builtin_amdgcn_kernarg_segment_ptr(); asm volatile("" : "+s"(kp)); Params p;
#pragma unroll
    for (int i = 0; i < 25; ++i) p.in[i] = kp->in[i];
    p.out = kp->out; p.ws = kp->ws; return p; }
#define WSP(T, off) ((T*)(p.ws + (off)))
__global__ void __launch_bounds__(512, 2) fwd_mega(Params p_unused) {
    extern __shared__ __attribute__((aligned(16))) unsigned char lds_raw[];
    LAS unsigned char* lds = (LAS unsigned char*)lds_raw;
    cg::grid_group grid = cg::this_grid();
    bool pe_on = false; unsigned long long pe_t = 0, pe_sum = 0; (void)pe_on; (void)pe_t; (void)pe_sum;
#ifdef PROBE_TOTAL
    const unsigned long long t_start = __builtin_amdgcn_s_memrealtime();
#endif
    volatile LAS unsigned* bst = (volatile LAS unsigned*)(lds + 131072);
    { const Params p = kparams(); unsigned* bar = WSP(unsigned, WS_MISC + MISC_BAR);
      (void)bar;
      if (threadIdx.x == 0) { bst[0] = 0u; bst[1] = 0u; }
      __syncthreads(); xcd_barrier_post(bar); }
#ifdef PROBE_BAR
    int bk = 0;
#define GSYNC() do { const Params p_ = kparams(); unsigned long long* arr_ = (unsigned long long*)(p_.ws + WS_MISC + MISC_BAR + 16384) + bk; ++bk; \
        if (threadIdx.x == 0) atomicMax(arr_, (unsigned long long)__builtin_amdgcn_s_memrealtime()); \
        xcd_barrier((unsigned*)(p_.ws + WS_MISC + MISC_BAR), bst); \
        const unsigned long long tl_ = __builtin_amdgcn_s_memrealtime(), ta_ = __hip_atomic_load(arr_, __ATOMIC_RELAXED, __HIP_MEMORY_SCOPE_AGENT); \
        const unsigned long long ov_ = (tl_ > ta_ ? tl_ - ta_ : 0ull) * PROBE_BAR; while (__builtin_amdgcn_s_memrealtime() - tl_ < ov_) __builtin_amdgcn_s_sleep(8); } while (0)
#else
#define GSYNC() do { const Params p_ = kparams(); xcd_barrier((unsigned*)(p_.ws + WS_MISC + MISC_BAR), bst); if (PROBE_END) { const unsigned long long tn_ = __builtin_amdgcn_s_memrealtime(); if (pe_on) pe_sum += tn_ - pe_t; pe_t = tn_; pe_on = false; } } while (0)
#endif
        { PH_BEGIN(0)
    { const Params p = kparams(); prep_weights(p, (LAS float*)lds, WSP(bf16_t, WS_WTS)); }
    { const Params p = kparams(); phase0_misc(p, WSP(bf16_t, WS_XB), WSP(unsigned long long, WS_SSP), WSP(float, WS_ROPE), WSP(int, WS_MISC + MISC_CNT)); }
          PH_END(0) }
    { const Params p = kparams(); if (p.ws == nullptr) grid.sync();     }
    GSYNC();
    for (int l = 0; l < 2; ++l) {
        { PH_BEGIN(1)
        { const Params p = kparams(); pg8::Sched<0, 11, 1024, 1024, 16> S{l_gdim(), l_bid()};
          EpiIn E{p.ws, 2 * l};
          pg8::gemm_phase(lds, WSP(bf16_t, WS_XB), WSP(bf16_t, WS_WTS) + (size_t)l * W_LAYER + W_IN, S, E); }
          PH_END(1) }
        GSYNC();
        { PH_BEGIN(2)
        { const Params p = kparams(); kmean_phase(WSP(bf16_t, WS_R + R_K), WSP(float, WS_MISC + MISC_KM)); }
          PH_END(2) }
        { PH_BEGIN(3)
        { const Params p = kparams(); pool_phase(WSP(bf16_t, WS_R + R_XA), WSP(bf16_t, WS_Y)); }
          PH_END(3) }
        { PH_BEGIN(4)
        { const Params p = kparams(); const LayerW w = layer_w(p, l); conv_phase(lds, WSP(bf16_t, WS_R + R_H), w, WSP(bf16_t, WS_Y)); }
          PH_END(4) }
        { PH_BEGIN(5)
        { const Params p = kparams(); const LayerW w = layer_w(p, l); sgu_phase(lds, WSP(bf16_t, WS_R + R_ZC), w, WSP(bf16_t, WS_Y)); }
          PH_END(5) }
        GSYNC();
        { PH_BEGIN(6)
        { const Params p = kparams(); gate_phase(lds, WSP(bf16_t, WS_R + R_Q), WSP(float, WS_MISC + MISC_KM), WSP(int, WS_MISC + MISC_CNT) + l * 1024, WSP(unsigned short, WS_R + R_LISTS)); }
          PH_END(6) }
        GSYNC();
        { PH_BEGIN(7)
        { const Params p = kparams(); attn_phase(lds, WSP(bf16_t, WS_R + R_Q), WSP(bf16_t, WS_R + R_K), WSP(bf16_t, WS_R + R_V), WSP(unsigned short, WS_R + R_LISTS), WSP(int, WS_MISC + MISC_CNT) + l * 1024, WSP(bf16_t, WS_R + R_PO), WSP(f32x2, WS_R + R_ML)); }
          PH_END(7) }
        GSYNC();
        { PH_BEGIN(8)
        { const Params p = kparams(); combine_phase(WSP(bf16_t, WS_R + R_PO), WSP(f32x2, WS_R + R_ML), WSP(bf16_t, WS_Y)); }
          PH_END(8) }
        GSYNC();
        { PH_BEGIN(9)
        { const Params p = kparams(); pg8::Sched<1, 16, 1280, 1280, 4> S{l_gdim(), l_bid()}; EpiProj E{WSP(bf16_t, WS_R)};
          pg8::gemm_phase(lds, WSP(bf16_t, WS_Y), WSP(bf16_t, WS_WTS) + (size_t)l * W_LAYER + W_P, S, E); }
          PH_END(9) }
        GSYNC();
        { PH_BEGIN(10)
        { const Params p = kparams(); pg8::Sched<0, 16, 1024, 1024, 16> S{l_gdim(), l_bid()};
          EpiGate E{WSP(unsigned long long, WS_SSP) + (size_t)(2 * l) * MTOK, p.in[5] + (size_t)l * 4096, WSP(bf16_t, WS_R), WSP(bf16_t, WS_Y)};
          pg8::gemm_phase(lds, WSP(bf16_t, WS_XB), WSP(bf16_t, WS_WTS) + (size_t)l * W_LAYER + W_G, S, E); }
          PH_END(10) }
        GSYNC();
        { PH_BEGIN(11)
        { const Params p = kparams(); pg8::Sched<0, 4, 1024, 1024, 16> S{l_gdim(), l_bid()};
          EpiRes E{WSP(bf16_t, WS_XB), WSP(unsigned long long, WS_SSP) + (size_t)(2 * l + 1) * MTOK};
          pg8::gemm_phase(lds, WSP(bf16_t, WS_Y), WSP(bf16_t, WS_WTS) + (size_t)l * W_LAYER + W_O, S, E); }
          PH_END(11) }
        GSYNC();
        { PH_BEGIN(12)
        { const Params p = kparams(); pg8::Sched<0, 22, 1024, 1024, 16> S{l_gdim(), l_bid()};
          EpiSwi E{WSP(unsigned long long, WS_SSP) + (size_t)(2 * l + 1) * MTOK, WSP(bf16_t, WS_R)};
          pg8::gemm_phase(lds, WSP(bf16_t, WS_XB), WSP(bf16_t, WS_WTS) + (size_t)l * W_LAYER + W_F1, S, E); }
          PH_END(12) }
        GSYNC();
        { PH_BEGIN(13)
        { const Params p = kparams(); pg8::Sched<0, 4, 2816, 2816, 44> S{l_gdim(), l_bid()};
          EpiRes E{WSP(bf16_t, WS_XB), WSP(unsigned long long, WS_SSP) + (size_t)(2 * l + 2) * MTOK};
          pg8::gemm_phase(lds, WSP(bf16_t, WS_R), WSP(bf16_t, WS_WTS) + (size_t)l * W_LAYER + W_F2, S, E); }
          PH_END(13) }
        GSYNC();
    }
#ifdef EXTRA_SYNCS
    for (int i = 0; i < EXTRA_SYNCS; ++i) GSYNC();
#endif
    { PH_BEGIN(14)
    { const Params p = kparams(); final_phase(WSP(bf16_t, WS_XB), p.out, WSP(unsigned long long, WS_SSP) + (size_t)4 * MTOK, p.in[24]); }
      PH_END(14) }
    if (PROBE_END) { const unsigned long long t1 = __builtin_amdgcn_s_memrealtime(); while (__builtin_amdgcn_s_memrealtime() - t1 < pe_sum) __builtin_amdgcn_s_sleep(8); }
#ifdef PROBE_TOTAL
    { const unsigned long long t1 = __builtin_amdgcn_s_memrealtime(), dt = t1 - t_start; while (__builtin_amdgcn_s_memrealtime() - t1 < dt) __builtin_amdgcn_s_sleep(8); }
#endif
}

extern "C" void kernel_launch(void* const* d_in, const int* in_sizes, int n_in, void* d_out, int out_size, void* d_ws, size_t ws_size, hipStream_t stream) {
    static int grid = 0;
    if (grid == 0) {
        int dev = 0, cus = 0, per_cu = 0;
        if (n_in != 25 || out_size != MTOK * DM || ws_size < WS_END) { fprintf(stderr, "kernel_launch: unexpected shapes / workspace (n_in %d out %d ws %zu)\n", n_in, out_size, ws_size); grid = -1; return; }
        (void)hipGetDevice(&dev); (void)hipDeviceGetAttribute(&cus, hipDeviceAttributeMultiprocessorCount, dev);
        (void)hipFuncSetAttribute((const void*)fwd_mega, hipFuncAttributeMaxDynamicSharedMemorySize, LDS_BYTES);
        (void)hipOccupancyMaxActiveBlocksPerMultiprocessor(&per_cu, (const void*)fwd_mega, 512, LDS_BYTES);
        grid = cus > 0 ? cus : 256;
    }
    if (grid < 0) return;
    (void)hipMemsetAsync((char*)d_ws + WS_MISC + MISC_BAR, 0, 32768, stream);
    Params p{};
    for (int i = 0; i < 25; ++i) p.in[i] = (const float*)d_in[i];
    p.out = (float*)d_out; p.ws = (unsigned char*)d_ws;
    void* args[] = {&p};
    hipError_t e = hipLaunchCooperativeKernel((const void*)fwd_mega, dim3(grid), dim3(512), args, LDS_BYTES, stream);
    if (e != hipSuccess) fprintf(stderr, "cooperative launch failed: %s (grid %d)\n", hipGetErrorString(e), grid);
}
```

```cpp
#include <hip/hip_runtime.h>
#include <hip/hip_cooperative_groups.h>
#include <cstdio>
namespace cg = cooperative_groups;
#define LAS __attribute__((address_space(3)))
#define DI __device__ __forceinline__
typedef unsigned short bf16_t;
typedef short bf16x8 __attribute__((ext_vector_type(8)));
typedef short s16x4 __attribute__((ext_vector_type(4)));
typedef float f32x4 __attribute__((ext_vector_type(4)));
typedef float f32x2 __attribute__((ext_vector_type(2)));
typedef unsigned u32x4 __attribute__((ext_vector_type(4)));
typedef unsigned u32x2 __attribute__((ext_vector_type(2)));

constexpr int SEQ = 16384, MTOK = 32768, DM = 1024, NIN = 2816, FF = 2816;
constexpr int LDS_BYTES = 131072 + 64;
constexpr size_t MiB = 1048576;
constexpr size_t WS_XB = 0, WS_WTS = 64 * MiB, WS_ROPE = 140 * MiB, WS_MISC = 148 * MiB, WS_Y = 150 * MiB, WS_R = 230 * MiB, WS_SSP = 494 * MiB, WS_END = 496 * MiB;
constexpr size_t R_Q = 0, R_K = 32 * MiB, R_V = 64 * MiB, R_LISTS = 96 * MiB, R_ML = 128 * MiB, R_XA = 136 * MiB, R_ZC = 152 * MiB, R_H = 184 * MiB, R_PO = 136 * MiB;
constexpr size_t W_IN = 0, W_G = W_IN + (size_t)2816 * 1024, W_P = W_G + (size_t)4096 * 1024, W_O = W_P + (size_t)1024 * 1280, W_F1 = W_O + (size_t)1024 * 1024, W_F2 = W_F1 + (size_t)5632 * 1024, W_LAYER = W_F2 + (size_t)1024 * 2816;
constexpr size_t MISC_SS = 0, MISC_KM = 5 * (size_t)MTOK * 4, MISC_CNT = MISC_KM + 1024 * 64 * 4, MISC_BAR = MISC_CNT + 2048 * 4;

DI unsigned pk2(float lo, float hi) { unsigned r; asm volatile("v_cvt_pk_bf16_f32 %0, %1, %2" : "=v"(r) : "v"(lo), "v"(hi)); return r; }
DI float bflo(unsigned u) { return __uint_as_float(u << 16); }
DI float bfhi(unsigned u) { return __uint_as_float(u & 0xffff0000u); }
DI float bf1(bf16_t u) { return __uint_as_float(((unsigned)u) << 16); }
DI float sigm(float z) { return __builtin_amdgcn_rcpf(1.0f + __expf(-z)); }
DI float gelu_t(float x) { return x * sigm(1.5957691216057308f * (x + 0.044715f * x * x * x)); }
DI u32x2 pk4(f32x4 v) { u32x2 w; w.x = pk2(v[0], v[1]); w.y = pk2(v[2], v[3]); return w; }

DI int l_tid() { int t = threadIdx.x; asm volatile("" : "+v"(t)); return t; }
DI int l_bid() { int b = blockIdx.x; asm volatile("" : "+s"(b)); return b; }
DI int l_gdim() { int b = gridDim.x; asm volatile("" : "+s"(b)); return b; }
DI float row_rs(const unsigned long long* ssp, int row) { return rsqrtf((float)ssp[row] * (1.0f / (1048576.0f * 1024.0f)) + 1e-6f); }
DI unsigned long long ss_fix(float sq) { return (unsigned long long)(sq * 1048576.0f + 0.5f); }
struct Params { const float* in[25]; float* out; unsigned char* ws; };

namespace pg8 {
constexpr int BM = 256, BK = 64, HALF = 128, HTB = HALF * BK * 2, STAGE_BYTES = 8 * HTB, NXCD = 8, WGM = 8;
DI int lds_byte(int r, int c) { const int st = (r >> 4) * 2 + (c >> 5), rr = r & 15, cc = c & 31, ob = rr * 64 + cc * 2; return st * 1024 + (ob ^ (((ob >> 9) & 1) << 5)); }
DI void stage_rc(int b, int& R, int& C) { const int st = b / 1024, sb = b % 1024, swz = sb ^ (((sb >> 9) & 1) << 5); R = (st >> 1) * 16 + swz / 64; C = (st & 1) * 32 + (swz % 64) / 2; }
DI int perm32(int rho) { const int n = rho >> 4, i = rho & 15; return 8 * (i >> 2) + 4 * n + (i & 3); }
struct Unit { int pm, pn, nt, aux; size_t aoff, boff; };
template <int MODE, int NN, int LDA, int LDB, int NT0, int NM = MTOK / 256, int PM0 = 0>
struct Sched {
    static constexpr int nM = NM, nN = NN, nwg = nM * nN, lda = LDA, ldb = LDB;
    int G, c;
    DI bool next(int i, Unit& u) const {
        const int L = i * G + c; if (L >= nwg) return false;
        int wgid = L; { constexpr int q = nwg / NXCD; const int xcd = wgid % NXCD, off = wgid / NXCD; wgid = xcd * q + off; }
        constexpr int nig = WGM * nN; const int gid = wgid / nig, fm = gid * WGM;
        const int pm = PM0 + fm + ((wgid % nig) % WGM), pn = (wgid % nig) / WGM;
        u.pm = pm;
        if (MODE == 0) { u.pn = pn; u.aux = 0; u.nt = NT0; u.aoff = (size_t)pm * BM * lda * 2; u.boff = (size_t)pn * BM * ldb * 2; }
        else { const int br = pn >> 2, pi = pn & 3; const int koff = br == 0 ? 0 : (br == 1 ? 256 : (br == 2 ? 768 : 1024));
               u.pn = pi; u.aux = br; u.nt = br == 1 ? 8 : 4; u.aoff = ((size_t)pm * BM * lda + koff) * 2; u.boff = ((size_t)pi * BM * ldb + koff) * 2; }
        return true;
    }
};

template <class Epi, class SchedT>
DI void gemm_phase(LAS unsigned char* lds, const bf16_t* A, const bf16_t* Bt, const SchedT& S, const Epi& E) {
    const int tid = l_tid(), wid = __builtin_amdgcn_readfirstlane(tid >> 6), lane = tid & 63, wr = wid >> 2, wc = wid & 3, fr = lane & 15, fq = lane >> 4;
    constexpr int lda = SchedT::lda, ldb = SchedT::ldb;
    unsigned voffA[2], voffB[2];
#pragma unroll
    for (int i = 0; i < 2; ++i) { int R, C; stage_rc(tid * 16 + i * 8192, R, C); const int Rb = Epi::PERM ? ((R & ~31) + perm32(R & 31)) : R;
        voffA[i] = (unsigned)(R * lda + C) * 2u; voffB[i] = (unsigned)(Rb * ldb + C) * 2u; }
    const size_t kstep = (size_t)(BK * 2);
    const size_t hstepA = (size_t)HALF * lda * 2, hstepB = (size_t)HALF * ldb * 2;
    const unsigned ldsw = (unsigned)wid * 1024u;
    const int aoff = lds_byte(wr * 64 + fr, fq * 8), boff = lds_byte(wc * 32 + fr, fq * 8);
#define PG8_SA(b, h) (((b) * 2 + (h)) * HTB)
#define PG8_SB(b, h) ((4 + (b) * 2 + (h)) * HTB)
#define PG8_STAGE(bufoff, gbase, voff) do { _Pragma("unroll") for (int _i = 0; _i < 2; ++_i) \
        __builtin_amdgcn_global_load_lds((const unsigned*)((const char*)(gbase) + (voff)[_i]), (LAS unsigned*)(lds + (bufoff) + ldsw + _i * 8192), 16, 0, 0); } while (0)
#define PG8_LDA(dst, b, h) do { _Pragma("unroll") for (int m = 0; m < 4; ++m) _Pragma("unroll") for (int k = 0; k < 2; ++k) dst[m][k] = *(const LAS bf16x8*)(lds + PG8_SA(b, h) + aoff + m * 2048 + k * 1024); } while (0)
#define PG8_LDB(dst, b, h) do { _Pragma("unroll") for (int n = 0; n < 2; ++n) _Pragma("unroll") for (int k = 0; k < 2; ++k) dst[n][k] = *(const LAS bf16x8*)(lds + PG8_SB(b, h) + boff + n * 2048 + k * 1024); } while (0)
#define PG8_MMA(ai, bj, At, Bt_) do { __builtin_amdgcn_s_setprio(1); _Pragma("unroll") for (int m = 0; m < 4; ++m) _Pragma("unroll") for (int n = 0; n < 2; ++n) _Pragma("unroll") for (int k = 0; k < 2; ++k) \
        acc[ai][bj][m][n] = __builtin_amdgcn_mfma_f32_16x16x32_bf16(Bt_[n][k], At[m][k], acc[ai][bj][m][n], 0, 0, 0); __builtin_amdgcn_s_setprio(0); } while (0)
#define PG8_WAIT_V(n) asm volatile("s_waitcnt vmcnt(" #n ")" ::: "memory")
#define PG8_WAIT_L(n) asm volatile("s_waitcnt lgkmcnt(" #n ")" ::: "memory")
#define PG8_BAR __builtin_amdgcn_s_barrier()
#define PG8_SCHED __builtin_amdgcn_sched_barrier(0)
    Unit cur, nxt; int ui = 0;
    if (!S.next(0, cur)) return;
    f32x4 acc[2][2][4][2];
#pragma unroll
    for (int a = 0; a < 2; ++a)
#pragma unroll
        for (int b = 0; b < 2; ++b)
#pragma unroll
            for (int m = 0; m < 4; ++m)
#pragma unroll
                for (int n = 0; n < 2; ++n) acc[a][b][m][n] = (f32x4){0.f, 0.f, 0.f, 0.f};
    bf16x8 At[4][2], B0[2][2], B1[2][2];
    const char* cA = (const char*)A + cur.aoff; const char* cB = (const char*)Bt + cur.boff;
    PG8_STAGE(PG8_SB(0, 0), cB, voffB); PG8_STAGE(PG8_SA(0, 0), cA, voffA); PG8_STAGE(PG8_SB(0, 1), cB + hstepB, voffB); PG8_STAGE(PG8_SA(0, 1), cA + hstepA, voffA);
    if (wr == 1) PG8_BAR;
    PG8_WAIT_V(4); PG8_BAR;
    PG8_STAGE(PG8_SB(1, 0), cB + kstep, voffB); PG8_STAGE(PG8_SA(1, 0), cA + kstep, voffA); PG8_STAGE(PG8_SB(1, 1), cB + hstepB + kstep, voffB);
    PG8_WAIT_V(6); PG8_BAR;
    for (;;) {
        const bool has_next = S.next(ui + 1, nxt);
        const char* nA = has_next ? (const char*)A + nxt.aoff : cA; const char* nB = has_next ? (const char*)Bt + nxt.boff : cB;
        const int nt = cur.nt;
        for (int t = 0; t < nt; t += 2) {
            const bool last = (t == nt - 2);
            const char* a1 = cA + (size_t)(t + 1) * kstep;
            const char* a2 = last ? nA : cA + (size_t)(t + 2) * kstep; const char* b2 = last ? nB : cB + (size_t)(t + 2) * kstep;
            const char* a3 = a2 + kstep; const char* b3 = b2 + kstep;
            PG8_LDB(B0, 0, 0); PG8_SCHED; PG8_LDA(At, 0, 0); PG8_STAGE(PG8_SA(1, 1), a1 + hstepA, voffA);
            PG8_WAIT_L(8); PG8_BAR; PG8_WAIT_L(0); PG8_MMA(0, 0, At, B0); PG8_BAR; PG8_SCHED;
            PG8_LDB(B1, 0, 1); PG8_STAGE(PG8_SB(0, 0), b2, voffB);
            PG8_BAR; PG8_WAIT_L(0); PG8_MMA(0, 1, At, B1); PG8_BAR;
            PG8_LDA(At, 0, 1); PG8_STAGE(PG8_SA(0, 0), a2, voffA);
            PG8_BAR; PG8_WAIT_L(0); PG8_MMA(1, 0, At, B0); PG8_BAR; PG8_SCHED;
            PG8_STAGE(PG8_SB(0, 1), b2 + hstepB, voffB);
            PG8_WAIT_V(6); PG8_BAR; PG8_MMA(1, 1, At, B1); PG8_BAR;
            PG8_LDB(B0, 1, 0); PG8_SCHED; PG8_LDA(At, 1, 0); PG8_STAGE(PG8_SA(0, 1), a2 + hstepA, voffA);
            PG8_WAIT_L(8); PG8_BAR; PG8_WAIT_L(0); PG8_MMA(0, 0, At, B0); PG8_BAR; PG8_SCHED;
            PG8_LDB(B1, 1, 1); PG8_STAGE(PG8_SB(1, 0), b3, voffB);
            PG8_BAR; PG8_WAIT_L(0); PG8_MMA(0, 1, At, B1); PG8_BAR;
            PG8_LDA(At, 1, 1); PG8_STAGE(PG8_SA(1, 0), a3, voffA);
            PG8_BAR; PG8_WAIT_L(0); PG8_MMA(1, 0, At, B0); PG8_BAR; PG8_SCHED;
            PG8_STAGE(PG8_SB(1, 1), b3 + hstepB, voffB);
            PG8_WAIT_V(6); PG8_BAR; PG8_MMA(1, 1, At, B1); PG8_BAR;
        }
        E(acc, cur, wr, wc, fr, fq);
        if (!has_next) break;
#pragma unroll
        for (int a = 0; a < 2; ++a)
#pragma unroll
            for (int b = 0; b < 2; ++b)
#pragma unroll
                for (int m = 0; m < 4; ++m)
#pragma unroll
                    for (int n = 0; n < 2; ++n) acc[a][b][m][n] = (f32x4){0.f, 0.f, 0.f, 0.f};
        cur = nxt; cA = nA; cB = nB; ++ui;
    }
    PG8_WAIT_V(0);
    if (wr == 0) PG8_BAR;
    PG8_BAR;
#undef PG8_SA
#undef PG8_SB
#undef PG8_STAGE
#undef PG8_LDA
#undef PG8_LDB
#undef PG8_MMA
#undef PG8_WAIT_V
#undef PG8_WAIT_L
#undef PG8_BAR
#undef PG8_SCHED
}
}
using pg8::Unit;
typedef const f32x4 (&AccRef)[2][2][4][2];

#define XB_TMO      128
#define XB_XCNT(j)  (256  + 64 * (j))
#define XB_XSUB(j)  (1280 + 64 * (j))
#define XB_XGEN(j)  (2304 + 64 * (j))
#define XB_TOP      3328
#define XB_TOPGEN   3392
#define XCD_BAR_WORDS 3456
#define XB_SPIN_CAP (1u << 22)
DI unsigned xb_ld(unsigned* p)              { return __hip_atomic_load(p, __ATOMIC_RELAXED, __HIP_MEMORY_SCOPE_AGENT); }
DI unsigned xb_add(unsigned* p, unsigned v) { return __hip_atomic_fetch_add(p, v, __ATOMIC_RELAXED, __HIP_MEMORY_SCOPE_AGENT); }
DI unsigned xb_xcc_id() { return (unsigned)__builtin_amdgcn_s_getreg((3 << 11) | 20) & 0xFu; }
#define XB_SPIN(cond, bar) do { unsigned _sp = 0; while (cond) { __builtin_amdgcn_s_sleep(1); \
    if ((++_sp & 255u) == 0u) { if (xb_ld(&(bar)[XB_TMO])) break; if (_sp > XB_SPIN_CAP) { atomicAdd(&(bar)[XB_TMO], 1u); break; } } } } while (0)
DI void xcd_barrier_post(unsigned* bar) { if (threadIdx.x == 0) (void)xb_add(&bar[XB_XCNT(xb_xcc_id())], 1u); }
DI void xcd_barrier_complete(unsigned* bar, unsigned x, unsigned& nloc, unsigned& nx) {
    const unsigned G = gridDim.x;
    unsigned sum, cnt, mine, sp = 0u;
    for (;;) {
        sum = 0u; cnt = 0u; mine = 0u;
#pragma unroll
        for (unsigned j = 0; j < 16; ++j) { const unsigned c = xb_ld(&bar[XB_XCNT(j)]); sum += c; cnt += (c > 0u) ? 1u : 0u; mine = (j == x) ? c : mine; }
        if (sum == G) break;
        __builtin_amdgcn_s_sleep(1);
        if ((++sp & 255u) == 0u) { if (xb_ld(&bar[XB_TMO])) break; if (sp > XB_SPIN_CAP) { atomicAdd(&bar[XB_TMO], 1u); break; } }
    }
    nloc = mine > 0u ? mine : 1u; nx = cnt > 0u ? cnt : 1u;
}
DI void xcd_barrier(unsigned* bar, volatile LAS unsigned* st) {
    asm volatile("s_waitcnt vmcnt(0)" ::: "memory");
    __syncthreads();
    if (threadIdx.x == 0) {
        const unsigned x = xb_xcc_id();
        __builtin_amdgcn_s_waitcnt(0);
        unsigned nloc = st[0], nx = st[1];
        if (nloc == 0u) { xcd_barrier_complete(bar, x, nloc, nx); st[0] = nloc; st[1] = nx; }
        const unsigned old = xb_add(&bar[XB_XSUB(x)], 1u);
        const unsigned gen = old / nloc;
        if (old + 1u == (gen + 1u) * nloc) {
            __builtin_amdgcn_fence(__ATOMIC_RELEASE, "agent");
            asm volatile("s_waitcnt vmcnt(0)" ::: "memory");
            const unsigned og = xb_add(&bar[XB_TOP], 1u);
            const unsigned tg = og / nx;
            if (og + 1u == (tg + 1u) * nx) xb_add(&bar[XB_TOPGEN], 1u);
            else XB_SPIN(xb_ld(&bar[XB_TOPGEN]) == tg, bar);
            __builtin_amdgcn_fence(__ATOMIC_ACQUIRE, "agent");
            xb_add(&bar[XB_XGEN(x)], 1u);
            asm volatile("s_waitcnt vmcnt(0)" ::: "memory");
        } else {
            XB_SPIN(xb_ld(&bar[XB_XGEN(x)]) == gen, bar);
            __builtin_amdgcn_fence(__ATOMIC_ACQUIRE, "agent");
            asm volatile("s_waitcnt vmcnt(0)" ::: "memory");
        }
    }
    __syncthreads();
}
struct EpiIn {
    static constexpr bool PERM = true; static constexpr int NST = 16;
    unsigned char* ws; int ssi;
    template <int TY> DI void run(AccRef acc, const Unit& u, int wr, int wc, int fr, int fq) const {
        const int pn = u.pn;
        const unsigned long long* ss = (const unsigned long long*)(ws + WS_SSP) + (size_t)ssi * MTOK; const float* rope = (const float*)(ws + WS_ROPE);
        bf16_t* XA = (bf16_t*)(ws + WS_R + R_XA); bf16_t* Q = (bf16_t*)(ws + WS_R + R_Q); bf16_t* K = (bf16_t*)(ws + WS_R + R_K); bf16_t* V = (bf16_t*)(ws + WS_R + R_V);
        bf16_t* ZC = (bf16_t*)(ws + WS_R + R_ZC); bf16_t* H = (bf16_t*)(ws + WS_R + R_H);
        float rsv[2][4];
#pragma unroll
        for (int ai = 0; ai < 2; ++ai)
#pragma unroll
            for (int m = 0; m < 4; ++m) rsv[ai][m] = row_rs(ss, u.pm * 256 + ai * 128 + wr * 64 + m * 16 + fr);
#pragma unroll
        for (int ai = 0; ai < 2; ++ai) {
          f32x4 rp[4][2][2];
          if (TY == 2) {
#pragma unroll
            for (int m = 0; m < 4; ++m)
#pragma unroll
                for (int w2 = 0; w2 < 1; ++w2) { const float* rb = rope + ((size_t)(u.pm * 256 + ai * 128 + wr * 64 + m * 16 + fr) * 32 + 16 * (wc & 1) + 4 * fq) * 2;
                    rp[m][0][0] = *(const f32x4*)rb; rp[m][0][1] = *(const f32x4*)(rb + 4); rp[m][1][0] = rp[m][0][0]; rp[m][1][1] = rp[m][0][1]; }
          }
#pragma unroll
            for (int m = 0; m < 4; ++m) {
                const int row = u.pm * 256 + ai * 128 + wr * 64 + m * 16 + fr;
                const float rs = rsv[ai][m];
#pragma unroll
                for (int bj = 0; bj < 2; ++bj) {
                    const f32x4 v0 = acc[ai][bj][m][0] * rs, v1 = acc[ai][bj][m][1] * rs;
                    if (TY == 0) {
                        bf16_t* dst; int ld, cb;
                        if (pn == 0) { dst = XA; ld = 256; cb = 0; } else { dst = V; ld = 512; cb = (pn - 5) * 256; }
                        u32x4 w; w.x = pk2(v0[0], v0[1]); w.y = pk2(v0[2], v0[3]); w.z = pk2(v1[0], v1[1]); w.w = pk2(v1[2], v1[3]);
                        *(u32x4*)(dst + (size_t)row * ld + cb + bj * 128 + wc * 32 + 8 * fq) = w;
                    } else if (TY == 1) {
                        u32x4 w; w.x = pk2(gelu_t(v0[0]), gelu_t(v0[1])); w.y = pk2(gelu_t(v0[2]), gelu_t(v0[3])); w.z = pk2(gelu_t(v1[0]), gelu_t(v1[1])); w.w = pk2(gelu_t(v1[2]), gelu_t(v1[3]));
                        *(u32x4*)(ZC + (size_t)row * 512 + (pn - 7) * 256 + bj * 128 + wc * 32 + 8 * fq) = w;
                    } else if (TY == 2) {
                        bf16_t* dst = pn >= 3 ? K : Q; const int hb = ((pn - 1) & 1) * 4 + bj * 2 + (wc >> 1); const int idx = 16 * (wc & 1) + 4 * fq;
                        const f32x4 r0 = rp[m][bj][0], r1 = rp[m][bj][1];
                        f32x4 o1, o2;
                        o1[0] = v0[0] * r0[0] - v1[0] * r0[1]; o2[0] = v1[0] * r0[0] + v0[0] * r0[1];
                        o1[1] = v0[1] * r0[2] - v1[1] * r0[3]; o2[1] = v1[1] * r0[2] + v0[1] * r0[3];
                        o1[2] = v0[2] * r1[0] - v1[2] * r1[1]; o2[2] = v1[2] * r1[0] + v0[2] * r1[1];
                        o1[3] = v0[3] * r1[2] - v1[3] * r1[3]; o2[3] = v1[3] * r1[2] + v0[3] * r1[3];
                        bf16_t* p = dst + (size_t)row * 512 + hb * 64 + idx;
                        *(u32x2*)p = pk4(o1); *(u32x2*)(p + 32) = pk4(o2);
                    } else {
                        const int blk = (pn - 9) * 4 + bj * 2 + (wc >> 1); const int idx = 32 * blk + 16 * (wc & 1) + 4 * fq;
                        f32x4 o; o[0] = v0[0] * sigm(v1[0]); o[1] = v0[1] * sigm(v1[1]); o[2] = v0[2] * sigm(v1[2]); o[3] = v0[3] * sigm(v1[3]);
                        *(u32x2*)(H + (size_t)row * 256 + idx) = pk4(o);
                    }
                }
            }
        }
    }
    DI void operator()(AccRef acc, const Unit& u, int wr, int wc, int fr, int fq) const {
        const int pn = u.pn;
        if (pn == 0 || pn == 5 || pn == 6) run<0>(acc, u, wr, wc, fr, fq);
        else if (pn == 7 || pn == 8) run<1>(acc, u, wr, wc, fr, fq);
        else if (pn <= 4) run<2>(acc, u, wr, wc, fr, fq);
        else run<3>(acc, u, wr, wc, fr, fq);
    }
};
struct EpiProj {
    static constexpr bool PERM = true; static constexpr int NST = 16;
    bf16_t* P;
    DI void operator()(AccRef acc, const Unit& u, int wr, int wc, int fr, int fq) const {
        const int br = u.aux;
#pragma unroll
        for (int ai = 0; ai < 2; ++ai)
#pragma unroll
            for (int m = 0; m < 4; ++m) {
                const int row = u.pm * 256 + ai * 128 + wr * 64 + m * 16 + fr;
#pragma unroll
                for (int bj = 0; bj < 2; ++bj) {
                    const f32x4 v0 = acc[ai][bj][m][0], v1 = acc[ai][bj][m][1];
                    u32x4 w; w.x = pk2(v0[0], v0[1]); w.y = pk2(v0[2], v0[3]); w.z = pk2(v1[0], v1[1]); w.w = pk2(v1[2], v1[3]);
                    *(u32x4*)(P + (size_t)row * 4096 + br * 1024 + u.pn * 256 + wc * 64 + bj * 32 + 8 * fq) = w;
                }
            }
    }
};
struct EpiGate {
    static constexpr bool PERM = true; static constexpr int NST = 8;
    const unsigned long long* ss; const float* bg; const bf16_t* P; bf16_t* MG;
    DI void operator()(AccRef acc, const Unit& u, int wr, int wc, int fr, int fq) const {
        const int oc = u.pn * 64 + 16 * wc + 4 * fq;
        const int ocp = (oc & ~255) + ((oc >> 5) & 3) * 64 + ((oc >> 7) & 1) * 32 + (oc & 31);
        float rsv[2][4];
#pragma unroll
        for (int ai = 0; ai < 2; ++ai)
#pragma unroll
            for (int m = 0; m < 4; ++m) rsv[ai][m] = row_rs(ss, u.pm * 256 + ai * 128 + wr * 64 + m * 16 + fr);
        f32x4 bv[2][2];
#pragma unroll
        for (int bj = 0; bj < 2; ++bj)
#pragma unroll
            for (int n = 0; n < 2; ++n) bv[bj][n] = *(const f32x4*)(bg + (2 * bj + n) * 1024 + oc);
#define GATE_PLOAD(dst, ai_, m_) do { _Pragma("unroll") for (int bj = 0; bj < 2; ++bj) { const bf16_t* pp = P + (size_t)(u.pm * 256 + (ai_) * 128 + wr * 64 + (m_) * 16 + fr) * 4096 + (2 * bj) * 1024 + ocp; \
            const u32x2 q0 = *(const u32x2*)pp, q1 = *(const u32x2*)(pp + 1024); dst[bj] = (u32x4){q0.x, q0.y, q1.x, q1.y}; } } while (0)
        u32x4 pa[4][2], pb[2][2], pc[2][2];
#pragma unroll
        for (int m = 0; m < 4; ++m) GATE_PLOAD(pa[m], 0, m);
#pragma unroll
        for (int m = 0; m < 2; ++m) GATE_PLOAD(pb[m], 1, m);
#define GATE_ROW(pvv, ai_, m_) do { const int row = u.pm * 256 + (ai_) * 128 + wr * 64 + (m_) * 16 + fr; const float rs = rsv[ai_][m_]; f32x4 o = (f32x4){0.f, 0.f, 0.f, 0.f}; \
            _Pragma("unroll") for (int bj = 0; bj < 2; ++bj) { const u32x4 pw = pvv[bj]; \
                const f32x4 g0 = acc[ai_][bj][m_][0] * rs + bv[bj][0], g1 = acc[ai_][bj][m_][1] * rs + bv[bj][1]; \
                o[0] += sigm(g0[0]) * bflo(pw.x) + sigm(g1[0]) * bflo(pw.z); o[1] += sigm(g0[1]) * bfhi(pw.x) + sigm(g1[1]) * bfhi(pw.z); \
                o[2] += sigm(g0[2]) * bflo(pw.y) + sigm(g1[2]) * bflo(pw.w); o[3] += sigm(g0[3]) * bfhi(pw.y) + sigm(g1[3]) * bfhi(pw.w); } \
            *(u32x2*)(MG + (size_t)row * 1024 + oc) = pk4(o); } while (0)
        GATE_ROW(pa[0], 0, 0); GATE_ROW(pa[1], 0, 1);
#pragma unroll
        for (int m = 0; m < 2; ++m) GATE_PLOAD(pc[m], 1, m + 2);
        GATE_ROW(pa[2], 0, 2); GATE_ROW(pa[3], 0, 3);
        GATE_ROW(pb[0], 1, 0); GATE_ROW(pb[1], 1, 1); GATE_ROW(pc[0], 1, 2); GATE_ROW(pc[1], 1, 3);
#undef GATE_PLOAD
#undef GATE_ROW
    }
};
struct EpiRes {
    static constexpr bool PERM = true; static constexpr int NST = 24;
    bf16_t* XB; unsigned long long* ss;
    DI void operator()(AccRef acc, const Unit& u, int wr, int wc, int fr, int fq) const {
        u32x4 bv[2][4][2];
#pragma unroll
        for (int ai = 0; ai < 2; ++ai)
#pragma unroll
            for (int m = 0; m < 4; ++m)
#pragma unroll
                for (int bj = 0; bj < 2; ++bj) bv[ai][m][bj] = *(const u32x4*)(XB + (size_t)(u.pm * 256 + ai * 128 + wr * 64 + m * 16 + fr) * 1024 + u.pn * 256 + bj * 128 + wc * 32 + 8 * fq);
#pragma unroll
        for (int ai = 0; ai < 2; ++ai)
#pragma unroll
            for (int m = 0; m < 4; ++m) {
                const int row = u.pm * 256 + ai * 128 + wr * 64 + m * 16 + fr; float sq = 0.f;
#pragma unroll
                for (int bj = 0; bj < 2; ++bj) {
                    const size_t off = (size_t)row * 1024 + u.pn * 256 + bj * 128 + wc * 32 + 8 * fq;
                    const u32x4 b0 = bv[ai][m][bj];
                    const f32x4 v0 = (f32x4){bflo(b0.x), bfhi(b0.x), bflo(b0.y), bfhi(b0.y)} + acc[ai][bj][m][0];
                    const f32x4 v1 = (f32x4){bflo(b0.z), bfhi(b0.z), bflo(b0.w), bfhi(b0.w)} + acc[ai][bj][m][1];
                    u32x4 w; w.x = pk2(v0[0], v0[1]); w.y = pk2(v0[2], v0[3]); w.z = pk2(v1[0], v1[1]); w.w = pk2(v1[2], v1[3]);
                    *(u32x4*)(XB + off) = w;
                    sq += ((v0[0] * v0[0] + v0[1] * v0[1]) + (v0[2] * v0[2] + v0[3] * v0[3])) + ((v1[0] * v1[0] + v1[1] * v1[1]) + (v1[2] * v1[2] + v1[3] * v1[3]));
                }
                sq += __shfl_xor(sq, 16); sq += __shfl_xor(sq, 32);
                if (fq == 0) atomicAdd(ss + row, ss_fix(sq));
            }
    }
};
struct EpiSwi {
    static constexpr bool PERM = true; static constexpr int NST = 8;
    const unsigned long long* ss; bf16_t* ACT;
    DI void operator()(AccRef acc, const Unit& u, int wr, int wc, int fr, int fq) const {
        float rsv[2][4];
#pragma unroll
        for (int ai = 0; ai < 2; ++ai)
#pragma unroll
            for (int m = 0; m < 4; ++m) rsv[ai][m] = row_rs(ss, u.pm * 256 + ai * 128 + wr * 64 + m * 16 + fr);
        const int idx = 128 * u.pn + 32 * wc + 8 * fq;
#pragma unroll
        for (int ai = 0; ai < 2; ++ai)
#pragma unroll
            for (int m = 0; m < 4; ++m) {
                const int row = u.pm * 256 + ai * 128 + wr * 64 + m * 16 + fr;
                const float rs = rsv[ai][m];
                u32x4 w;
                { const f32x4 g = acc[ai][0][m][0] * rs, uu = acc[ai][0][m][1] * rs;
                  w.x = pk2(g[0] * sigm(g[0]) * uu[0], g[1] * sigm(g[1]) * uu[1]); w.y = pk2(g[2] * sigm(g[2]) * uu[2], g[3] * sigm(g[3]) * uu[3]); }
                { const f32x4 g = acc[ai][1][m][0] * rs, uu = acc[ai][1][m][1] * rs;
                  w.z = pk2(g[0] * sigm(g[0]) * uu[0], g[1] * sigm(g[1]) * uu[1]); w.w = pk2(g[2] * sigm(g[2]) * uu[2], g[3] * sigm(g[3]) * uu[3]); }
                *(u32x4*)(ACT + (size_t)row * FF + idx) = w;
            }
    }
};
struct LayerW { const float *g_mix, *w_in, *w_gate, *b_gate, *pool_w, *pool_scale, *sgu_g, *sgu_b, *sgu_w, *sgu_bs, *conv_w, *conv_b, *conv_g, *conv_nb, *wpa, *wpb, *wpc, *wpd, *wo, *g_ffn, *wf1, *wf2; };
DI LayerW layer_w(const Params& p, int l) {
    LayerW w;
    w.g_mix = p.in[2] + (size_t)l * 1024; w.w_in = p.in[3] + (size_t)l * 1024 * 2816; w.w_gate = p.in[4] + (size_t)l * 1024 * 4096; w.b_gate = p.in[5] + (size_t)l * 4096;
    w.pool_w = p.in[6] + (size_t)l * 4 * 64 * 64; w.pool_scale = p.in[7] + (size_t)l * 256; w.sgu_g = p.in[8] + (size_t)l * 256; w.sgu_b = p.in[9] + (size_t)l * 256;
    w.sgu_w = p.in[10] + (size_t)l * 4 * 128 * 128; w.sgu_bs = p.in[11] + (size_t)l * 4 * 128; w.conv_w = p.in[12] + (size_t)l * 31 * 256; w.conv_b = p.in[13] + (size_t)l * 256;
    w.conv_g = p.in[14] + (size_t)l * 256; w.conv_nb = p.in[15] + (size_t)l * 256; w.wpa = p.in[16] + (size_t)l * 256 * 1024; w.wpb = p.in[17] + (size_t)l * 512 * 1024;
    w.wpc = p.in[18] + (size_t)l * 256 * 1024; w.wpd = p.in[19] + (size_t)l * 256 * 1024; w.wo = p.in[20] + (size_t)l * 1024 * 1024; w.g_ffn = p.in[21] + (size_t)l * 1024;
    w.wf1 = p.in[22] + (size_t)l * 1024 * 5632; w.wf2 = p.in[23] + (size_t)l * 2816 * 1024;
    return w;
}
DI int orig_in(int nl) {
    const int tile = nl >> 8;
    if (tile == 0 || (tile >= 5 && tile <= 8)) return nl;
    const int l = nl & 63, w = l >> 5, fq = (l >> 3) & 3, n = (l >> 2) & 1, e = l & 3, idx = 16 * w + 4 * fq + e;
    if (tile <= 4) return (nl & ~63) + 32 * n + idx;
    const int blk = (nl - 2304) >> 6; return 2304 + (n ? 256 : 0) + 32 * blk + idx;
}
DI int orig_gate(int nl) { const int pn = nl >> 8, l = nl & 255, bj = l >> 7, wc = (l >> 5) & 3, fq = (l >> 3) & 3, n = (l >> 2) & 1, e = l & 3; return (2 * bj + n) * 1024 + 64 * pn + 16 * wc + 4 * fq + e; }
DI int orig_ffn(int nl) { const int pn = nl >> 8, l = nl & 255, bj = l >> 7, wc = (l >> 5) & 3, fq = (l >> 3) & 3, n = (l >> 2) & 1, e = l & 3; const int idx = 128 * pn + 32 * wc + 8 * fq + 4 * bj + e; return n ? 2816 + idx : idx; }

DI void prep_weights(const Params& p, LAS float* tile, bf16_t* wts) {
    const int TIDX = l_tid(), BIDX = l_bid(), GDIM = l_gdim();
    const int tid = TIDX;
    LAS float* PWs = tile + 256 * 65; LAS float* WAs = PWs + 64 * 65;
    for (int job = BIDX; job < 2 * 1104; job += GDIM) {
        const int l = job / 1104; int j = job % 1104; int type, tn, tk;
        if (j < 176) { type = 0; tn = j / 4; tk = j % 4; }
        else if (j < 432) { j -= 176; type = 1; tn = j / 4; tk = j % 4; }
        else if (j < 512) { j -= 432; type = 2; tn = j / 5; tk = j % 5; }
        else if (j < 576) { j -= 512; type = 3; tn = j / 4; tk = j % 4; }
        else if (j < 928) { j -= 576; type = 4; tn = j / 4; tk = j % 4; }
        else { j -= 928; type = 5; tn = j / 11; tk = j % 11; }
        const LayerW w = layer_w(p, l);
        const int n0 = tn * 64, k0 = tk * 256;
        const int n = tid & 63, kb = tid >> 6, nl = n0 + n;
        const int oc = type == 0 ? orig_in(nl) : (type == 1 ? orig_gate(nl) : (type == 4 ? orig_ffn(nl) : nl));
        __syncthreads();
        if (type == 2 && k0 == 0) {
            for (int g = 0; g < 4; ++g) {
#pragma unroll
                for (int i = 0; i < 8; ++i) { const int e = tid + 512 * i, r = e >> 6, cc = e & 63;
                    PWs[r * 65 + cc] = w.pool_w[(size_t)(g * 64 + r) * 64 + cc] * w.pool_scale[g * 64 + cc];
                    WAs[r * 64 + cc] = w.wpa[(size_t)(g * 64 + r) * 1024 + n0 + cc]; }
                __syncthreads();
#pragma unroll
                for (int i = 0; i < 8; ++i) { const int c = kb + 8 * i; float sacc = 0.f;
#pragma unroll 8
                    for (int d = 0; d < 64; ++d) sacc += PWs[c * 65 + d] * WAs[d * 64 + n];
                    tile[(g * 64 + c) * 65 + n] = sacc; }
                __syncthreads();
            }
        } else {
            const float* src; size_t ld; const float* gs = nullptr;
            if (type == 0) { src = w.w_in; ld = 2816; gs = w.g_mix; }
            else if (type == 1) { src = w.w_gate; ld = 4096; gs = w.g_mix; }
            else if (type == 2) { const int kk = k0; src = kk < 768 ? w.wpb + (size_t)(kk - 256) * 1024 : (kk < 1024 ? w.wpc + (size_t)(kk - 768) * 1024 : w.wpd + (size_t)(kk - 1024) * 1024); src -= (size_t)k0 * 1024; ld = 1024; }
            else if (type == 3) { src = w.wo; ld = 1024; }
            else if (type == 4) { src = w.wf1; ld = 5632; gs = w.g_ffn; }
            else { src = w.wf2; ld = 1024; }
            float v[32];
#pragma unroll
            for (int i = 0; i < 32; ++i) v[i] = src[(size_t)(k0 + kb + 8 * i) * ld + oc];
            if (gs) {
#pragma unroll
                for (int i = 0; i < 32; ++i) v[i] *= gs[k0 + kb + 8 * i]; }
#pragma unroll
            for (int i = 0; i < 32; ++i) tile[(kb + 8 * i) * 65 + n] = v[i];
        }
        __syncthreads();
        {
            const int nn = tid >> 3, kc = (tid & 7) * 32;
            const size_t woff = type == 0 ? W_IN : (type == 1 ? W_G : (type == 2 ? W_P : (type == 3 ? W_O : (type == 4 ? W_F1 : W_F2))));
            const int ldd = type == 2 ? 1280 : (type == 5 ? 2816 : 1024);
            bf16_t* dst = wts + (size_t)l * W_LAYER + woff + (size_t)(n0 + nn) * ldd + k0 + kc;
#pragma unroll
            for (int q = 0; q < 4; ++q) { u32x4 o;
                o.x = pk2(tile[(kc + 8 * q + 0) * 65 + nn], tile[(kc + 8 * q + 1) * 65 + nn]); o.y = pk2(tile[(kc + 8 * q + 2) * 65 + nn], tile[(kc + 8 * q + 3) * 65 + nn]);
                o.z = pk2(tile[(kc + 8 * q + 4) * 65 + nn], tile[(kc + 8 * q + 5) * 65 + nn]); o.w = pk2(tile[(kc + 8 * q + 6) * 65 + nn], tile[(kc + 8 * q + 7) * 65 + nn]);
                *(u32x4*)(dst + 8 * q) = o; }
        }
    }
}
DI void phase0_misc(const Params& p, bf16_t* XB, unsigned long long* ss, float* rope, int* cnt) {
    const int TIDX = l_tid(), BIDX = l_bid(), GDIM = l_gdim(); (void)TIDX; (void)BIDX; (void)GDIM;
    const int tid = TIDX, lane = tid & 63, wid = tid >> 6;
    const size_t gsz = (size_t)GDIM * 512, gid = (size_t)BIDX * 512 + tid;
    const float* x = p.in[0];
    for (int row0 = (BIDX * 8 + wid) * 4; row0 < MTOK; row0 += GDIM * 32) {
        f32x4 v[4][4];
#pragma unroll
        for (int r = 0; r < 4; ++r)
#pragma unroll
            for (int i = 0; i < 4; ++i) v[r][i] = *(const f32x4*)(x + (size_t)(row0 + r) * 1024 + i * 256 + lane * 4);
#pragma unroll
        for (int r = 0; r < 4; ++r) { float sq = 0.f;
#pragma unroll
            for (int i = 0; i < 4; ++i) { const f32x4 q = v[r][i]; sq += (q[0] * q[0] + q[1] * q[1]) + (q[2] * q[2] + q[3] * q[3]); *(u32x2*)(XB + (size_t)(row0 + r) * 1024 + i * 256 + lane * 4) = pk4(q); }
#pragma unroll
            for (int o = 32; o >= 1; o >>= 1) sq += __shfl_xor(sq, o);
            if (lane == 0) ss[row0 + r] = ss_fix(sq); }
    }
    const int* pos = (const int*)p.in[1];
    for (size_t i = gid; i < (size_t)MTOK * 32; i += gsz) {
        const int row = (int)(i >> 5), fi = (int)(i & 31);
        const float inv = 1.0f / powf(10000.0f, (float)fi * (1.0f / 32.0f));
        const float ang = (float)pos[row] * inv;
        const double r = (double)ang * 0.15915494309189535; const float fr = (float)(r - rint(r));
        rope[i * 2] = __builtin_amdgcn_cosf(fr); rope[i * 2 + 1] = __builtin_amdgcn_sinf(fr);
    }
    for (size_t i = gid; i < 2048; i += gsz) cnt[i] = 0;
    for (size_t i = gid; i < (size_t)4 * MTOK; i += gsz) ss[MTOK + i] = 0ull;
}

DI void kmean_phase(const bf16_t* K, float* km) {
    const int TIDX = l_tid(), BIDX = l_bid(), GDIM = l_gdim(); (void)TIDX; (void)BIDX; (void)GDIM;
    const int lane = TIDX & 63, wid = TIDX >> 6, dp = lane & 31, par = lane >> 5;
    for (int it = BIDX * 8 + wid; it < 1024; it += GDIM * 8) {
        const int b = it >> 9, h = (it >> 6) & 7, n = it & 63;
        const bf16_t* base = K + ((size_t)(b * SEQ + n * 256)) * 512 + h * 64 + 2 * dp;
        float s0 = 0.f, s1 = 0.f;
#pragma unroll 16
        for (int i = 0; i < 128; ++i) { const unsigned u = *(const unsigned*)(base + (size_t)(2 * i + par) * 512); s0 += bflo(u); s1 += bfhi(u); }
        s0 += __shfl_xor(s0, 32); s1 += __shfl_xor(s1, 32);
        if (par == 0) { f32x2 o; o.x = s0 * (1.0f / 256.0f); o.y = s1 * (1.0f / 256.0f); *(f32x2*)(km + (size_t)it * 64 + 2 * dp) = o; }
    }
}
template <int W>
DI void pool_run(const bf16_t* XA, bf16_t* Y, int run, int c8) {
    const int tok0 = run * 8, tl0 = tok0 & (SEQ - 1), ch = (W == 2 ? 0 : (W == 4 ? 64 : (W == 8 ? 128 : 192))) + c8 * 8;
    u32x4 rows[W + 7];
#pragma unroll
    for (int r = 0; r < W + 7; ++r) { rows[r] = (u32x4){0u, 0u, 0u, 0u}; if (tl0 - (W - 1) + r >= 0) rows[r] = *(const u32x4*)(XA + (size_t)(tok0 - (W - 1) + r) * 256 + ch); }
    float s[8];
#pragma unroll
    for (int i = 0; i < 8; ++i) s[i] = 0.f;
#define POOL_ADD(v, sgn) do { s[0] += sgn bflo((v).x); s[1] += sgn bfhi((v).x); s[2] += sgn bflo((v).y); s[3] += sgn bfhi((v).y); s[4] += sgn bflo((v).z); s[5] += sgn bfhi((v).z); s[6] += sgn bflo((v).w); s[7] += sgn bfhi((v).w); } while (0)
#pragma unroll
    for (int r = 0; r < W - 1; ++r) POOL_ADD(rows[r], +);
#pragma unroll
    for (int o = 0; o < 8; ++o) {
        POOL_ADD(rows[W - 1 + o], +);
        const u32x4 c = rows[W - 1 + o]; const int tl = tl0 + o; const float inv = 1.0f / (float)(tl + 1 < W ? tl + 1 : W);
        u32x4 ov; ov.x = pk2(s[0] * inv - bflo(c.x), s[1] * inv - bfhi(c.x)); ov.y = pk2(s[2] * inv - bflo(c.y), s[3] * inv - bfhi(c.y)); ov.z = pk2(s[4] * inv - bflo(c.z), s[5] * inv - bfhi(c.z)); ov.w = pk2(s[6] * inv - bflo(c.w), s[7] * inv - bfhi(c.w));
        *(u32x4*)(Y + (size_t)(tok0 + o) * 1280 + ch) = ov;
        POOL_ADD(rows[o], -);
    }
#undef POOL_ADD
}
DI void pool_phase(const bf16_t* XA, bf16_t* Y) {
    const int TIDX = l_tid(), BIDX = l_bid(), GDIM = l_gdim();
    const int gsz = GDIM * 512, gid = BIDX * 512 + TIDX;
    for (int idx = gid; idx < 131072; idx += gsz) {
        const int g = idx >> 15, run = (idx & 32767) >> 3, c8 = idx & 7;
        if (g == 0) pool_run<2>(XA, Y, run, c8); else if (g == 1) pool_run<4>(XA, Y, run, c8); else if (g == 2) pool_run<8>(XA, Y, run, c8); else pool_run<16>(XA, Y, run, c8);
    }
}
DI void conv_phase(LAS unsigned char* lds, const bf16_t* H, const LayerW& w, bf16_t* Y) {
    const int TIDX = l_tid(), BIDX = l_bid(), GDIM = l_gdim(); (void)TIDX; (void)BIDX; (void)GDIM;
    LAS bf16_t* HS = (LAS bf16_t*)lds;
    LAS float* CS = (LAS float*)(lds + 48128);
    const int tid = TIDX, lane = tid & 63, wid = tid >> 6;
    for (int tile = BIDX; tile < MTOK / 64; tile += GDIM) {
        const int t0 = tile * 64, tl0 = t0 & (SEQ - 1);
        __syncthreads();
        for (int q = tid; q < 94 * 32; q += 512) { const int r = q >> 5, cc = (q & 31) * 8; u32x4 v = (u32x4){0u, 0u, 0u, 0u};
            if (tl0 - 30 + r >= 0) v = *(const u32x4*)(H + (size_t)(t0 - 30 + r) * 256 + cc);
            *(LAS u32x4*)(HS + r * 256 + cc) = v; }
        __syncthreads();
        {
            const int c = tid & 255, hf = tid >> 8; float wj[31];
#pragma unroll
            for (int j = 0; j < 31; ++j) wj[j] = w.conv_w[j * 256 + c];
            const float cb = w.conv_b[c];
            for (int chunk = 0; chunk < 4; ++chunk) {
                const int base = 32 * hf + 8 * chunk; float o[8];
#pragma unroll
                for (int i = 0; i < 8; ++i) o[i] = cb;
#pragma unroll
                for (int i = 0; i < 38; ++i) { const float hv = bf1(HS[(base + i) * 256 + c]);
#pragma unroll
                    for (int oo = 0; oo < 8; ++oo) { const int j = i - oo; if (j >= 0 && j < 31) o[oo] += wj[j] * hv; } }
#pragma unroll
                for (int oo = 0; oo < 8; ++oo) CS[(base + oo) * 260 + c] = o[oo];
            }
        }
        __syncthreads();
        {
            const f32x4 gg = *(const f32x4*)(w.conv_g + 4 * lane), bb = *(const f32x4*)(w.conv_nb + 4 * lane);
            for (int i = 0; i < 8; ++i) { const int tk = wid * 8 + i;
                const f32x4 v = *(const LAS f32x4*)(CS + tk * 260 + 4 * lane);
                float s = (v[0] + v[1]) + (v[2] + v[3]);
#pragma unroll
                for (int o = 32; o >= 1; o >>= 1) s += __shfl_xor(s, o);
                const float mu = s * (1.0f / 256.0f); const f32x4 d = v - mu;
                float q = (d[0] * d[0] + d[1] * d[1]) + (d[2] * d[2] + d[3] * d[3]);
#pragma unroll
                for (int o = 32; o >= 1; o >>= 1) q += __shfl_xor(q, o);
                const float rstd = rsqrtf(q * (1.0f / 256.0f) + 1e-6f);
                f32x4 y = d * rstd * gg + bb;
                y[0] *= sigm(y[0]); y[1] *= sigm(y[1]); y[2] *= sigm(y[2]); y[3] *= sigm(y[3]);
                *(u32x2*)(Y + (size_t)(t0 + tk) * 1280 + 1024 + 4 * lane) = pk4(y); }
        }
    }
}
DI void sgu_phase(LAS unsigned char* lds, const bf16_t* ZC, const LayerW& w, bf16_t* Y) {
    const int TIDX = l_tid(), BIDX = l_bid(), GDIM = l_gdim();
    LAS bf16_t* VT = (LAS bf16_t*)lds;
    const int tid = TIDX, lane = tid & 63, wid = __builtin_amdgcn_readfirstlane(tid >> 6), qi = lane & 15, gq = lane >> 4;
    for (int chunk = BIDX; chunk < MTOK / 128; chunk += GDIM) {
        const int t0 = chunk * 128;
        __syncthreads();
        {
            const f32x4 gg = *(const f32x4*)(w.sgu_g + 4 * lane), bb = *(const f32x4*)(w.sgu_b + 4 * lane);
            u32x2 raw[16];
#pragma unroll
            for (int i = 0; i < 16; ++i) raw[i] = *(const u32x2*)(ZC + (size_t)(t0 + wid * 16 + i) * 512 + 256 + 4 * lane);
#pragma unroll
            for (int i = 0; i < 16; ++i) { const int tl = wid * 16 + i;
                const f32x4 v = (f32x4){bflo(raw[i].x), bfhi(raw[i].x), bflo(raw[i].y), bfhi(raw[i].y)};
                float s = (v[0] + v[1]) + (v[2] + v[3]);
#pragma unroll
                for (int o = 32; o >= 1; o >>= 1) s += __shfl_xor(s, o);
                const float mu = s * (1.0f / 256.0f); const f32x4 d = v - mu;
                float q = (d[0] * d[0] + d[1] * d[1]) + (d[2] * d[2] + d[3] * d[3]);
#pragma unroll
                for (int o = 32; o >= 1; o >>= 1) q += __shfl_xor(q, o);
                const float rstd = rsqrtf(q * (1.0f / 256.0f) + 1e-6f);
                const f32x4 y = d * rstd * gg + bb;
                const unsigned p01 = pk2(y[0], y[1]), p23 = pk2(y[2], y[3]);
                const int tc = (tl + 8 * (lane & 15)) & 127;
                VT[(4 * lane + 0) * 136 + tc] = (bf16_t)(p01 & 0xffffu); VT[(4 * lane + 1) * 136 + tc] = (bf16_t)(p01 >> 16);
                VT[(4 * lane + 2) * 136 + tc] = (bf16_t)(p23 & 0xffffu); VT[(4 * lane + 3) * 136 + tc] = (bf16_t)(p23 >> 16); }
        }
        __syncthreads();
        {
            const int nks = (wid >> 1) + 1, t = wid * 16 + qi;
            f32x4 wa[4][4][2];
#pragma unroll
            for (int g = 0; g < 4; ++g)
#pragma unroll
                for (int ks = 0; ks < 4; ++ks) if (ks < nks) { const float* src = w.sgu_w + ((size_t)g * 128 + t) * 128 + 32 * ks + 8 * gq; wa[g][ks][0] = *(const f32x4*)src; wa[g][ks][1] = *(const f32x4*)(src + 4); }
            float bs[4];
#pragma unroll
            for (int g = 0; g < 4; ++g) bs[g] = w.sgu_bs[g * 128 + t];
#pragma unroll
            for (int g = 0; g < 4; ++g) {
                u32x2 ur[4];
#pragma unroll
                for (int nt = 0; nt < 4; ++nt) ur[nt] = *(const u32x2*)(ZC + (size_t)(t0 + t) * 512 + g * 64 + 16 * nt + 4 * gq);
                bf16x8 Wf[4];
#pragma unroll
                for (int ks = 0; ks < 4; ++ks) { u32x4 pk = (u32x4){0u, 0u, 0u, 0u};
                    if (ks < nks) { const f32x4 a = wa[g][ks][0], b = wa[g][ks][1]; const int s0 = 32 * ks + 8 * gq;
                        pk.x = pk2(s0 + 0 <= t ? a[0] : 0.f, s0 + 1 <= t ? a[1] : 0.f); pk.y = pk2(s0 + 2 <= t ? a[2] : 0.f, s0 + 3 <= t ? a[3] : 0.f);
                        pk.z = pk2(s0 + 4 <= t ? b[0] : 0.f, s0 + 5 <= t ? b[1] : 0.f); pk.w = pk2(s0 + 6 <= t ? b[2] : 0.f, s0 + 7 <= t ? b[3] : 0.f); }
                    Wf[ks] = __builtin_bit_cast(bf16x8, pk); }
#pragma unroll
                for (int nt = 0; nt < 4; ++nt) {
                    f32x4 acc = (f32x4){0.f, 0.f, 0.f, 0.f};
#pragma unroll
                    for (int ks = 0; ks < 4; ++ks) if (ks < nks) {
                        const bf16x8 vf = *(const LAS bf16x8*)(VT + (g * 64 + 16 * nt + qi) * 136 + ((32 * ks + 8 * gq + 8 * ((4 * nt + (qi >> 2)) & 15)) & 127));
                        acc = __builtin_amdgcn_mfma_f32_16x16x32_bf16(vf, Wf[ks], acc, 0, 0, 0); }
                    const int ch = g * 64 + 16 * nt + 4 * gq;
                    f32x4 o; o[0] = bflo(ur[nt].x) * (acc[0] + bs[g]); o[1] = bfhi(ur[nt].x) * (acc[1] + bs[g]); o[2] = bflo(ur[nt].y) * (acc[2] + bs[g]); o[3] = bfhi(ur[nt].y) * (acc[3] + bs[g]);
                    *(u32x2*)(Y + (size_t)(t0 + t) * 1280 + 768 + ch) = pk4(o);
                }
            }
        }
    }
}
typedef float f32x16 __attribute__((ext_vector_type(16)));
#define TOP3_INS(s_, n_) do { const float ss_ = (s_); const int nn_ = (n_); \
        if (ss_ > v0 || (ss_ == v0 && nn_ < i0)) { v2 = v1; i2 = i1; v1 = v0; i1 = i0; v0 = ss_; i0 = nn_; } \
        else if (ss_ > v1 || (ss_ == v1 && nn_ < i1)) { v2 = v1; i2 = i1; v1 = ss_; i1 = nn_; } \
        else if (ss_ > v2 || (ss_ == v2 && nn_ < i2)) { v2 = ss_; i2 = nn_; } } while (0)
DI void gate_phase(LAS unsigned char* lds, const bf16_t* Q, const float* km, int* cnt, unsigned short* lists) {
    const int TIDX = l_tid(), BIDX = l_bid(), GDIM = l_gdim();
    LAS bf16_t* KMH = (LAS bf16_t*)lds;
    LAS bf16_t* KML = (LAS bf16_t*)(lds + 9216);
    LAS int* HIST = (LAS int*)(lds + 18432); LAS int* BASE = HIST + 64;
    const int tid = TIDX, lane = tid & 63, wid = __builtin_amdgcn_readfirstlane(tid >> 6), r = lane & 31, h5 = lane >> 5;
    for (int item = BIDX; item < 512; item += GDIM) {
        const int b = item >> 8, h = (item >> 5) & 7, seg = b ? 31 - (item & 31) : (item & 31);
        __syncthreads();
        { const float* src = km + (size_t)(b * 8 + h) * 4096 + tid * 8; const f32x4 a = *(const f32x4*)src, c = *(const f32x4*)(src + 4);
          const float f[8] = {a[0], a[1], a[2], a[3], c[0], c[1], c[2], c[3]}; unsigned hi[4], lo[4];
#pragma unroll
          for (int i = 0; i < 4; ++i) { hi[i] = pk2(f[2 * i], f[2 * i + 1]); lo[i] = pk2(f[2 * i] - bflo(hi[i]), f[2 * i + 1] - bfhi(hi[i])); }
          const int n = tid >> 3, d0 = (tid & 7) * 8;
          *(LAS u32x4*)(KMH + n * 72 + d0) = (u32x4){hi[0], hi[1], hi[2], hi[3]}; *(LAS u32x4*)(KML + n * 72 + d0) = (u32x4){lo[0], lo[1], lo[2], lo[3]};
          if (tid < 64) HIST[tid] = 0; }
        __syncthreads();
        const int t = seg * 512 + tid, blk = t >> 8;
        int ri0 = 0, ri1 = 0, ri2 = 0;
#pragma unroll
        for (int qt = 0; qt < 2; ++qt) {
            bf16x8 Qf[4];
            { const bf16_t* qp = Q + ((size_t)(b * SEQ + seg * 512 + wid * 64 + qt * 32 + r)) * 512 + h * 64 + 8 * h5;
              Qf[0] = *(const bf16x8*)qp; Qf[1] = *(const bf16x8*)(qp + 16); Qf[2] = *(const bf16x8*)(qp + 32); Qf[3] = *(const bf16x8*)(qp + 48); }
            float v0 = -3.0e38f, v1 = -3.0e38f, v2 = -3.0e38f; int i0 = 64, i1 = 64, i2 = 64;
#pragma unroll
            for (int nt = 0; nt < 2; ++nt) {
                f32x16 c;
#pragma unroll
                for (int i = 0; i < 16; ++i) c[i] = 0.f;
#pragma unroll
                for (int ks = 0; ks < 4; ++ks) {
                    const bf16x8 kh = *(const LAS bf16x8*)(KMH + (32 * nt + r) * 72 + 16 * ks + 8 * h5), kl = *(const LAS bf16x8*)(KML + (32 * nt + r) * 72 + 16 * ks + 8 * h5);
                    c = __builtin_amdgcn_mfma_f32_32x32x16_bf16(kh, Qf[ks], c, 0, 0, 0); c = __builtin_amdgcn_mfma_f32_32x32x16_bf16(kl, Qf[ks], c, 0, 0, 0); }
                if (32 * nt < blk) {
#pragma unroll
                    for (int i = 0; i < 16; ++i) { const int n = 32 * nt + (i & 3) + 8 * (i >> 2) + 4 * h5; if (n < blk) TOP3_INS(c[i], n); } }
            }
            { const float p0 = __shfl_xor(v0, 32), p1 = __shfl_xor(v1, 32), p2 = __shfl_xor(v2, 32); const int j0 = __shfl_xor(i0, 32), j1 = __shfl_xor(i1, 32), j2 = __shfl_xor(i2, 32);
              if (j0 < 64) TOP3_INS(p0, j0); if (j1 < 64) TOP3_INS(p1, j1); if (j2 < 64) TOP3_INS(p2, j2); }
            if (h5 == qt) { ri0 = i0; ri1 = i1; ri2 = i2; }
        }
        const int i0 = ri0, i1 = ri1, i2 = ri2;
        const int nv = blk < 3 ? blk : 3; const int lb = (b * 8 + h) * 64;
        int r0 = 0, r1 = 0, r2 = 0;
        if (nv > 0) r0 = __hip_atomic_fetch_add(HIST + i0, 1, __ATOMIC_RELAXED, __HIP_MEMORY_SCOPE_WORKGROUP);
        if (nv > 1) r1 = __hip_atomic_fetch_add(HIST + i1, 1, __ATOMIC_RELAXED, __HIP_MEMORY_SCOPE_WORKGROUP);
        if (nv > 2) r2 = __hip_atomic_fetch_add(HIST + i2, 1, __ATOMIC_RELAXED, __HIP_MEMORY_SCOPE_WORKGROUP);
        __syncthreads();
        if (tid < 64) { const int hc = HIST[tid]; BASE[tid] = hc > 0 ? atomicAdd(cnt + lb + tid, hc) : 0; }
        __syncthreads();
        if (nv > 0) lists[(size_t)(lb + i0) * SEQ + BASE[i0] + r0] = (unsigned short)((t << 2) | 0);
        if (nv > 1) lists[(size_t)(lb + i1) * SEQ + BASE[i1] + r1] = (unsigned short)((t << 2) | 1);
        if (nv > 2) lists[(size_t)(lb + i2) * SEQ + BASE[i2] + r2] = (unsigned short)((t << 2) | 2);
    }
}
DI void att_core(LAS bf16_t* KS, LAS bf16_t* VT, const bf16x8 (&Qf)[4], bool causal, int wid, int r, int h5, float& mx_out, float& ls_out, f32x16 (&oa)[2]) {
    const float C2 = 0.125f * 1.4426950408889634f;
    f32x16 sa[8];
#pragma unroll
    for (int T = 0; T < 8; ++T) {
        f32x16 a;
#pragma unroll
        for (int i = 0; i < 16; ++i) a[i] = 0.f;
#pragma unroll
        for (int ks = 0; ks < 4; ++ks) { const bf16x8 kf = *(const LAS bf16x8*)(KS + (32 * T + r) * 72 + 16 * ks + 8 * h5); a = __builtin_amdgcn_mfma_f32_32x32x16_bf16(kf, Qf[ks], a, 0, 0, 0); }
        sa[T] = a;
    }
    if (causal) {
        const int lim = 32 * wid + r - 4 * h5;
#pragma unroll
        for (int T = 0; T < 8; ++T)
#pragma unroll
            for (int i = 0; i < 16; ++i) if (32 * T + (i & 3) + 8 * (i >> 2) > lim) sa[T][i] = -1.0e30f;
    }
    float mx = -1.0e30f;
#pragma unroll
    for (int T = 0; T < 8; ++T)
#pragma unroll
        for (int i = 0; i < 16; ++i) mx = fmaxf(mx, sa[T][i]);
    mx = fmaxf(mx, __shfl_xor(mx, 32));
    const f32x2 nm = (f32x2){-mx * C2, -mx * C2}, c2 = (f32x2){C2, C2};
    f32x2 lsv = (f32x2){0.f, 0.f};
#pragma unroll
    for (int T = 0; T < 8; ++T)
#pragma unroll
        for (int i = 0; i < 8; ++i) { f32x2 v = (f32x2){sa[T][2 * i], sa[T][2 * i + 1]}; v = __builtin_elementwise_fma(v, c2, nm);
            v.x = __builtin_amdgcn_exp2f(v.x); v.y = __builtin_amdgcn_exp2f(v.y); lsv += v; sa[T][2 * i] = v.x; sa[T][2 * i + 1] = v.y; }
    float ls = lsv.x + lsv.y;
    ls += __shfl_xor(ls, 32);
#pragma unroll
    for (int dt = 0; dt < 2; ++dt)
#pragma unroll
        for (int i = 0; i < 16; ++i) oa[dt][i] = 0.f;
#pragma unroll
    for (int T = 0; T < 8; ++T) {
#pragma unroll
        for (int s = 0; s < 2; ++s) {
            u32x4 pw; pw.x = pk2(sa[T][8 * s + 0], sa[T][8 * s + 1]); pw.y = pk2(sa[T][8 * s + 2], sa[T][8 * s + 3]); pw.z = pk2(sa[T][8 * s + 4], sa[T][8 * s + 5]); pw.w = pk2(sa[T][8 * s + 6], sa[T][8 * s + 7]);
            const bf16x8 pf = __builtin_bit_cast(bf16x8, pw);
#pragma unroll
            for (int dt = 0; dt < 2; ++dt) {
                const s16x4 va = *(const LAS s16x4*)(VT + (32 * dt + r) * 260 + 32 * T + 16 * s + 4 * h5), vb = *(const LAS s16x4*)(VT + (32 * dt + r) * 260 + 32 * T + 16 * s + 8 + 4 * h5);
                const bf16x8 vf = __builtin_shufflevector(va, vb, 0, 1, 2, 3, 4, 5, 6, 7);
                oa[dt] = __builtin_amdgcn_mfma_f32_32x32x16_bf16(vf, pf, oa[dt], 0, 0, 0);
            }
        }
    }
    mx_out = mx; ls_out = ls;
}
DI void attn_phase(LAS unsigned char* lds, const bf16_t* Q, const bf16_t* K, const bf16_t* V, const unsigned short* lists, const int* cnt, bf16_t* PO, f32x2* ML) {
    const int TIDX = l_tid(), BIDX = l_bid(), GDIM = l_gdim();
    LAS int* pre = (LAS int*)lds;
    LAS int* cntS = (LAS int*)(lds + 4608);
    LAS bf16_t* KS = (LAS bf16_t*)(lds + 12288);
    LAS bf16_t* VT = (LAS bf16_t*)(lds + 12288 + 36864);
    const int tid = TIDX, lane = tid & 63, wid = __builtin_amdgcn_readfirstlane(tid >> 6), r = lane & 31, h5 = lane >> 5;
    __syncthreads();
    {
        const int c0 = cnt[2 * tid], c1 = cnt[2 * tid + 1];
        cntS[2 * tid] = c0; cntS[2 * tid + 1] = c1;
        const int a = ((c0 + 255) >> 8) + 1, b2 = ((c1 + 255) >> 8) + 1, s = a + b2; int inc = s;
#pragma unroll
        for (int o = 1; o < 64; o <<= 1) { const int v = __shfl_up(inc, o); if (lane >= o) inc += v; }
        if (lane == 63) pre[1032 + wid] = inc;
        __syncthreads();
        int woff = 0; for (int i = 0; i < wid; ++i) woff += pre[1032 + i];
        const int ex = woff + inc - s; pre[2 * tid] = ex; pre[2 * tid + 1] = ex + a; if (tid == 511) pre[1024] = ex + s;
        __syncthreads();
    }
    const int total = pre[1024], per = (total + GDIM - 1) / GDIM;
    const int it0 = BIDX * per, it1 = (it0 + per < total) ? it0 + per : total;
    if (it0 >= it1) return;
    const float C2 = 0.125f * 1.4426950408889634f;
    int L, tile;
    { int lo = 0, hi = 1023; while (lo < hi) { const int mid = (lo + hi + 1) >> 1; if (pre[mid] <= it0) lo = mid; else hi = mid - 1; } L = lo; tile = it0 - pre[lo]; }
    int curL = -1;
#define ATT_DESC(L_, tile_, tq_, slot_, valid_, causal_) do { const int cntL_ = cntS[L_], ng_ = (cntL_ + 255) >> 8; causal_ = (tile_) >= ng_; \
        if (!(causal_)) { const int idx_ = (tile_) * 256 + wid * 32 + r; valid_ = idx_ < cntL_; const unsigned e_ = (valid_) ? (unsigned)lists[(size_t)(L_) * SEQ + idx_] : 0u; tq_ = (int)(e_ >> 2); slot_ = (int)(e_ & 3u); } \
        else { tq_ = ((L_) & 63) * 256 + wid * 32 + r; slot_ = 3; valid_ = true; } } while (0)
#define ATT_LOADQ(Qd, L_, tq_) do { const bf16_t* qp_ = Q + ((size_t)((L_) >> 9) * SEQ + (tq_)) * 512 + (((L_) >> 6) & 7) * 64 + 8 * h5; \
        Qd[0] = *(const bf16x8*)qp_; Qd[1] = *(const bf16x8*)(qp_ + 16); Qd[2] = *(const bf16x8*)(qp_ + 32); Qd[3] = *(const bf16x8*)(qp_ + 48); } while (0)
    int tq, slot; bool valid, causal;
    ATT_DESC(L, tile, tq, slot, valid, causal);
    bf16x8 Qf[4];
    ATT_LOADQ(Qf, L, tq);
    for (int it = it0; it < it1; ++it) {
        int nL = L, ntile = tile + 1; if (ntile >= pre[L + 1] - pre[L]) { nL = L + 1; ntile = 0; }
        const bool has_next = it + 1 < it1;
        int ntq = 0, nslot = 0; bool nvalid = false, ncausal = false;
        if (has_next) ATT_DESC(nL, ntile, ntq, nslot, nvalid, ncausal);
        const int b = L >> 9, h = (L >> 6) & 7, n = L & 63;
        if (L != curL) {
            __syncthreads();
            { const int key = tid >> 1, part = tid & 1; const bf16_t* src = K + ((size_t)(b * SEQ + n * 256 + key)) * 512 + h * 64 + part * 32;
#pragma unroll
              for (int i = 0; i < 4; ++i) *(LAS u32x4*)(KS + key * 72 + part * 32 + 8 * i) = *(const u32x4*)(src + 8 * i); }
            { const int key = tid & 255, hf = tid >> 8; const bf16_t* src = V + ((size_t)(b * SEQ + n * 256 + key)) * 512 + h * 64 + hf * 32;
#pragma unroll
              for (int i = 0; i < 4; ++i) { const u32x4 v = *(const u32x4*)(src + 8 * i); const int d0 = hf * 32 + 8 * i;
                  VT[(d0 + 0) * 260 + key] = (bf16_t)(v.x & 0xffffu); VT[(d0 + 1) * 260 + key] = (bf16_t)(v.x >> 16); VT[(d0 + 2) * 260 + key] = (bf16_t)(v.y & 0xffffu); VT[(d0 + 3) * 260 + key] = (bf16_t)(v.y >> 16);
                  VT[(d0 + 4) * 260 + key] = (bf16_t)(v.z & 0xffffu); VT[(d0 + 5) * 260 + key] = (bf16_t)(v.z >> 16); VT[(d0 + 6) * 260 + key] = (bf16_t)(v.w & 0xffffu); VT[(d0 + 7) * 260 + key] = (bf16_t)(v.w >> 16); } }
            __syncthreads();
            curL = L;
        }
        const size_t tokg = (size_t)b * SEQ + tq;
        bf16x8 nQ[4] = {Qf[0], Qf[1], Qf[2], Qf[3]};
        float mx, ls; f32x16 oa[2];
        if (has_next) ATT_LOADQ(nQ, nL, ntq);
        att_core(KS, VT, Qf, causal, wid, r, h5, mx, ls, oa);
        if (valid) {
            const float inv = 1.0f / ls; const size_t pidx = (tokg * 8 + h) * 4 + slot;
#pragma unroll
            for (int dt = 0; dt < 2; ++dt)
#pragma unroll
                for (int gq = 0; gq < 4; ++gq) { f32x4 o; o[0] = oa[dt][4 * gq] * inv; o[1] = oa[dt][4 * gq + 1] * inv; o[2] = oa[dt][4 * gq + 2] * inv; o[3] = oa[dt][4 * gq + 3] * inv;
                    *(u32x2*)(PO + pidx * 64 + 32 * dt + 8 * gq + 4 * h5) = pk4(o); }
            if (h5 == 0) { f32x2 ml; ml.x = mx * C2; ml.y = ls; ML[pidx] = ml; }
        }
        L = nL; tile = ntile; tq = ntq; slot = nslot; valid = nvalid; causal = ncausal; Qf[0] = nQ[0]; Qf[1] = nQ[1]; Qf[2] = nQ[2]; Qf[3] = nQ[3];
    }
#undef ATT_DESC
#undef ATT_LOADQ
}
DI void combine_phase(const bf16_t* PO, const f32x2* ML, bf16_t* Y) {
    const int TIDX = l_tid(), BIDX = l_bid(), GDIM = l_gdim(); (void)TIDX; (void)BIDX; (void)GDIM;
    const size_t gsz = (size_t)GDIM * 512, gid = (size_t)BIDX * 512 + TIDX;
    for (size_t idx = gid; idx < (size_t)MTOK * 64; idx += gsz) {
        const size_t th = idx >> 3; const int part = (int)(idx & 7); const int tok = (int)(th >> 3), h = (int)(th & 7);
        const int blk = (tok & (SEQ - 1)) >> 8, nv = blk < 3 ? blk : 3;
        const f32x4 m01 = *(const f32x4*)(ML + th * 4), m23 = *(const f32x4*)(ML + th * 4 + 2);
        const float m[4] = {m01[0], m01[2], m23[0], m23[2]}, l[4] = {m01[1], m01[3], m23[1], m23[3]};
        float M = m[3];
#pragma unroll
        for (int j = 0; j < 3; ++j) if (j < nv) M = fmaxf(M, m[j]);
        float acc[8], den = 0.f;
#pragma unroll
        for (int i = 0; i < 8; ++i) acc[i] = 0.f;
#pragma unroll
        for (int j = 0; j < 4; ++j) if (j == 3 || j < nv) {
            const float wgt = l[j] * __builtin_amdgcn_exp2f(m[j] - M); den += wgt;
            const u32x4 v = *(const u32x4*)(PO + (th * 4 + j) * 64 + part * 8);
            acc[0] += wgt * bflo(v.x); acc[1] += wgt * bfhi(v.x); acc[2] += wgt * bflo(v.y); acc[3] += wgt * bfhi(v.y); acc[4] += wgt * bflo(v.z); acc[5] += wgt * bfhi(v.z); acc[6] += wgt * bflo(v.w); acc[7] += wgt * bfhi(v.w);
        }
        const float inv = 1.0f / den;
        u32x4 o; o.x = pk2(acc[0] * inv, acc[1] * inv); o.y = pk2(acc[2] * inv, acc[3] * inv); o.z = pk2(acc[4] * inv, acc[5] * inv); o.w = pk2(acc[6] * inv, acc[7] * inv);
        *(u32x4*)(Y + (size_t)tok * 1280 + 256 + h * 64 + part * 8) = o;
    }
}
DI void final_phase(const bf16_t* XB, float* out, const unsigned long long* ss, const float* g) {
    const int TIDX = l_tid(), BIDX = l_bid(), GDIM = l_gdim();
    const size_t gsz = (size_t)GDIM * 512, gid = (size_t)BIDX * 512 + TIDX;
    for (size_t i = gid; i < (size_t)MTOK * 128; i += gsz) {
        const int row = (int)(i >> 7), c8 = (int)(i & 127) * 8;
        const float rs = row_rs(ss, row);
        const u32x4 v = *(const u32x4*)(XB + i * 8); const f32x4 g0 = *(const f32x4*)(g + c8), g1 = *(const f32x4*)(g + c8 + 4);
        f32x4 o0, o1; o0[0] = bflo(v.x) * rs * g0[0]; o0[1] = bfhi(v.x) * rs * g0[1]; o0[2] = bflo(v.y) * rs * g0[2]; o0[3] = bfhi(v.y) * rs * g0[3];
        o1[0] = bflo(v.z) * rs * g1[0]; o1[1] = bfhi(v.z) * rs * g1[1]; o1[2] = bflo(v.w) * rs * g1[2]; o1[3] = bfhi(v.w) * rs * g1[3];
        *(f32x4*)(out + i * 8) = o0; *(f32x4*)(out + i * 8 + 4) = o1;
    }
}

#ifndef PROBE_MASK
#define PROBE_MASK 0u
#endif
#ifndef PROBE_END
#define PROBE_END 0u
#endif
#define PH_BEGIN(k) unsigned long long _t0_##k = 0; if ((PROBE_MASK >> (k)) & 1u) _t0_##k = __builtin_amdgcn_s_memrealtime(); if ((PROBE_END >> (k)) & 1u) { pe_on = true; }
#define PH_END(k) if ((PROBE_MASK >> (k)) & 1u) { const unsigned long long _t1 = __builtin_amdgcn_s_memrealtime(), _dt = _t1 - _t0_##k; while (__builtin_amdgcn_s_memrealtime() - _t1 < _dt) __builtin_amdgcn_s_sleep(8); }
typedef const __attribute__((address_space(4))) Params* KParams;
DI Params kparams() { KParams kp = (KParams)__builtin_amdgcn_kernarg_segment_ptr(); asm volatile("" : "+s"(kp)); Params p;
#pragma unroll
    for (int i = 0; i < 25; ++i) p.in[i] = kp->in[i];
    p.out = kp->out; p.ws = kp->ws; return p; }
#define WSP(T, off) ((T*)(p.ws + (off)))
__global__ void __launch_bounds__(512, 2) fwd_mega(Params p_unused) {
    extern __shared__ __attribute__((aligned(16))) unsigned char lds_raw[];
    LAS unsigned char* lds = (LAS unsigned char*)lds_raw;
    cg::grid_group grid = cg::this_grid();
    bool pe_on = false; unsigned long long pe_t = 0, pe_sum = 0; (void)pe_on; (void)pe_t; (void)pe_sum;
#ifdef PROBE_TOTAL
    const unsigned long long t_start = __builtin_amdgcn_s_memrealtime();
#endif
    volatile LAS unsigned* bst = (volatile LAS unsigned*)(lds + 131072);
    { const Params p = kparams(); unsigned* bar = WSP(unsigned, WS_MISC + MISC_BAR);
      (void)bar;
      if (threadIdx.x == 0) { bst[0] = 0u; bst[1] = 0u; }
      __syncthreads(); xcd_barrier_post(bar); }
#ifdef PROBE_BAR
    int bk = 0;
#define GSYNC() do { const Params p_ = kparams(); unsigned long long* arr_ = (unsigned long long*)(p_.ws + WS_MISC + MISC_BAR + 16384) + bk; ++bk; \
        if (threadIdx.x == 0) atomicMax(arr_, (unsigned long long)__builtin_amdgcn_s_memrealtime()); \
        xcd_barrier((unsigned*)(p_.ws + WS_MISC + MISC_BAR), bst); \
        const unsigned long long tl_ = __builtin_amdgcn_s_memrealtime(), ta_ = __hip_atomic_load(arr_, __ATOMIC_RELAXED, __HIP_MEMORY_SCOPE_AGENT); \
        const unsigned long long ov_ = (tl_ > ta_ ? tl_ - ta_ : 0ull) * PROBE_BAR; while (__builtin_amdgcn_s_memrealtime() - tl_ < ov_) __builtin_amdgcn_s_sleep(8); } while (0)
#else
#define GSYNC() do { const Params p_ = kparams(); xcd_barrier((unsigned*)(p_.ws + WS_MISC + MISC_BAR), bst); if (PROBE_END) { const unsigned long long tn_ = __builtin_amdgcn_s_memrealtime(); if (pe_on) pe_sum += tn_ - pe_t; pe_t = tn_; pe_on = false; } } while (0)
#endif
        { PH_BEGIN(0)
    { const Params p = kparams(); prep_weights(p, (LAS float*)lds, WSP(bf16_t, WS_WTS)); }
    { const Params p = kparams(); phase0_misc(p, WSP(bf16_t, WS_XB), WSP(unsigned long long, WS_SSP), WSP(float, WS_ROPE), WSP(int, WS_MISC + MISC_CNT)); }
          PH_END(0) }
    { const Params p = kparams(); if (p.ws == nullptr) grid.sync();     }
    GSYNC();
    for (int l = 0; l < 2; ++l) {
        { PH_BEGIN(1)
        { const Params p = kparams(); pg8::Sched<0, 11, 1024, 1024, 16> S{l_gdim(), l_bid()};
          EpiIn E{p.ws, 2 * l};
          pg8::gemm_phase(lds, WSP(bf16_t, WS_XB), WSP(bf16_t, WS_WTS) + (size_t)l * W_LAYER + W_IN, S, E); }
          PH_END(1) }
        GSYNC();
        { PH_BEGIN(2)
        { const Params p = kparams(); kmean_phase(WSP(bf16_t, WS_R + R_K), WSP(float, WS_MISC + MISC_KM)); }
          PH_END(2) }
        { PH_BEGIN(3)
        { const Params p = kparams(); pool_phase(WSP(bf16_t, WS_R + R_XA), WSP(bf16_t, WS_Y)); }
          PH_END(3) }
        { PH_BEGIN(4)
        { const Params p = kparams(); const LayerW w = layer_w(p, l); conv_phase(lds, WSP(bf16_t, WS_R + R_H), w, WSP(bf16_t, WS_Y)); }
          PH_END(4) }
        { PH_BEGIN(5)
        { const Params p = kparams(); const LayerW w = layer_w(p, l); sgu_phase(lds, WSP(bf16_t, WS_R + R_ZC), w, WSP(bf16_t, WS_Y)); }
          PH_END(5) }
        GSYNC();
        { PH_BEGIN(6)
        { const Params p = kparams(); gate_phase(lds, WSP(bf16_t, WS_R + R_Q), WSP(float, WS_MISC + MISC_KM), WSP(int, WS_MISC + MISC_CNT) + l * 1024, WSP(unsigned short, WS_R + R_LISTS)); }
          PH_END(6) }
        GSYNC();
        { PH_BEGIN(7)
        { const Params p = kparams(); attn_phase(lds, WSP(bf16_t, WS_R + R_Q), WSP(bf16_t, WS_R + R_K), WSP(bf16_t, WS_R + R_V), WSP(unsigned short, WS_R + R_LISTS), WSP(int, WS_MISC + MISC_CNT) + l * 1024, WSP(bf16_t, WS_R + R_PO), WSP(f32x2, WS_R + R_ML)); }
          PH_END(7) }
        GSYNC();
        { PH_BEGIN(8)
        { const Params p = kparams(); combine_phase(WSP(bf16_t, WS_R + R_PO), WSP(f32x2, WS_R + R_ML), WSP(bf16_t, WS_Y)); }
          PH_END(8) }
        GSYNC();
        { PH_BEGIN(9)
        { const Params p = kparams(); pg8::Sched<1, 16, 1280, 1280, 4> S{l_gdim(), l_bid()}; EpiProj E{WSP(bf16_t, WS_R)};
          pg8::gemm_phase(lds, WSP(bf16_t, WS_Y), WSP(bf16_t, WS_WTS) + (size_t)l * W_LAYER + W_P, S, E); }
          PH_END(9) }
        GSYNC();
        { PH_BEGIN(10)
        { const Params p = kparams(); pg8::Sched<0, 16, 1024, 1024, 16> S{l_gdim(), l_bid()};
          EpiGate E{WSP(unsigned long long, WS_SSP) + (size_t)(2 * l) * MTOK, p.in[5] + (size_t)l * 4096, WSP(bf16_t, WS_R), WSP(bf16_t, WS_Y)};
          pg8::gemm_phase(lds, WSP(bf16_t, WS_XB), WSP(bf16_t, WS_WTS) + (size_t)l * W_LAYER + W_G, S, E); }
          PH_END(10) }
        GSYNC();
        { PH_BEGIN(11)
        { const Params p = kparams(); pg8::Sched<0, 4, 1024, 1024, 16> S{l_gdim(), l_bid()};
          EpiRes E{WSP(bf16_t, WS_XB), WSP(unsigned long long, WS_SSP) + (size_t)(2 * l + 1) * MTOK};
          pg8::gemm_phase(lds, WSP(bf16_t, WS_Y), WSP(bf16_t, WS_WTS) + (size_t)l * W_LAYER + W_O, S, E); }
          PH_END(11) }
        GSYNC();
        { PH_BEGIN(12)
        { const Params p = kparams(); pg8::Sched<0, 22, 1024, 1024, 16> S{l_gdim(), l_bid()};
          EpiSwi E{WSP(unsigned long long, WS_SSP) + (size_t)(2 * l + 1) * MTOK, WSP(bf16_t, WS_R)};
          pg8::gemm_phase(lds, WSP(bf16_t, WS_XB), WSP(bf16_t, WS_WTS) + (size_t)l * W_LAYER + W_F1, S, E); }
          PH_END(12) }
        GSYNC();
        { PH_BEGIN(13)
        { const Params p = kparams(); pg8::Sched<0, 4, 2816, 2816, 44> S{l_gdim(), l_bid()};
          EpiRes E{WSP(bf16_t, WS_XB), WSP(unsigned long long, WS_SSP) + (size_t)(2 * l + 2) * MTOK};
          pg8::gemm_phase(lds, WSP(bf16_t, WS_R), WSP(bf16_t, WS_WTS) + (size_t)l * W_LAYER + W_F2, S, E); }
          PH_END(13) }
        GSYNC();
    }
#ifdef EXTRA_SYNCS
    for (int i = 0; i < EXTRA_SYNCS; ++i) GSYNC();
#endif
    { PH_BEGIN(14)
    { const Params p = kparams(); final_phase(WSP(bf16_t, WS_XB), p.out, WSP(unsigned long long, WS_SSP) + (size_t)4 * MTOK, p.in[24]); }
      PH_END(14) }
    if (PROBE_END) { const unsigned long long t1 = __builtin_amdgcn_s_memrealtime(); while (__builtin_amdgcn_s_memrealtime() - t1 < pe_sum) __builtin_amdgcn_s_sleep(8); }
#ifdef PROBE_TOTAL
    { const unsigned long long t1 = __builtin_amdgcn_s_memrealtime(), dt = t1 - t_start; while (__builtin_amdgcn_s_memrealtime() - t1 < dt) __builtin_amdgcn_s_sleep(8); }
#endif
}

extern "C" void kernel_launch(void* const* d_in, const int* in_sizes, int n_in, void* d_out, int out_size, void* d_ws, size_t ws_size, hipStream_t stream) {
    static int grid = 0;
    if (grid == 0) {
        int dev = 0, cus = 0, per_cu = 0;
        if (n_in != 25 || out_size != MTOK * DM || ws_size < WS_END) { fprintf(stderr, "kernel_launch: unexpected shapes / workspace (n_in %d out %d ws %zu)\n", n_in, out_size, ws_size); grid = -1; return; }
        (void)hipGetDevice(&dev); (void)hipDeviceGetAttribute(&cus, hipDeviceAttributeMultiprocessorCount, dev);
        (void)hipFuncSetAttribute((const void*)fwd_mega, hipFuncAttributeMaxDynamicSharedMemorySize, LDS_BYTES);
        (void)hipOccupancyMaxActiveBlocksPerMultiprocessor(&per_cu, (const void*)fwd_mega, 512, LDS_BYTES);
        grid = cus > 0 ? cus : 256;
    }
    if (grid < 0) return;
    (void)hipMemsetAsync((char*)d_ws + WS_MISC + MISC_BAR, 0, 32768, stream);
    Params p{};
    for (int i = 0; i < 25; ++i) p.in[i] = (const float*)d_in[i];
    p.out = (float*)d_out; p.ws = (unsigned char*)d_ws;
    void* args[] = {&p};
    hipError_t e = hipLaunchCooperativeKernel((const void*)fwd_mega, dim3(grid), dim3(512), args, LDS_BYTES, stream);
    if (e != hipSuccess) fprintf(stderr, "cooperative launch failed: %s (grid %d)\n", hipGetErrorString(e), grid);
}
```
